# Optimizing an MI355X kernel written in HIP

```python
import math
import jax, jax.numpy as jnp
from jax import lax
import numpy as np

D_MODEL = 1024
BATCH = 4
SEQ = 8192
DEPTH = 2

N_A_LAYERS = DEPTH // 2
N_B_LAYERS = DEPTH - N_A_LAYERS
CONV_WIDTH = 3
DIL_GROUPS = ((128, 1), (512, 4), (2048, 16))
N_ATTN_GROUPS = len(DIL_GROUPS)
HEAD_DIM = 128
HEADS_PER_GROUP = D_MODEL // HEAD_DIM
ATTN_GROUP_WIDTH = HEADS_PER_GROUP * HEAD_DIM
Q_WIDTH = N_ATTN_GROUPS * ATTN_GROUP_WIDTH
N_ATTN_HEADS = N_ATTN_GROUPS * HEADS_PER_GROUP
BLOCK = 128
NUM_BUCKETS = 32
MAX_DISTANCE = 2048
N_EXPERTS = 16
N_EXPERT_GROUPS = 4
EXPERTS_PER_GROUP = N_EXPERTS // N_EXPERT_GROUPS
TOP_K = 2
EXPERT_FF = D_MODEL // 4
ALPHA = (2 * DEPTH) ** 0.25
BETA = (8 * DEPTH) ** -0.25
LN_EPS = 1e-5
NEG_INF = -1e30

kernel_name = 'yoco_shortconv_dilated_attn_grouped_moe'


def layer_norm(x, g, b):
    xf = x.astype(jnp.float32)
    mu = jnp.mean(xf, axis=-1, keepdims=True)
    var = jnp.mean(jnp.square(xf - mu), axis=-1, keepdims=True)
    y = (xf - mu) * lax.rsqrt(var + LN_EPS) * g.astype(jnp.float32) + b.astype(jnp.float32)
    return y.astype(x.dtype)


def modulate(x, shift, scale):
    return x * (1 + scale[:, None, :]) + shift[:, None, :]


def short_conv_mixer(h, w_in, conv_w, w_out):
    bgate, cgate, v = jnp.split(h @ w_in, 3, axis=-1)
    u = cgate * v
    u = lax.conv_general_dilated(
        u, conv_w[:, None, :], window_strides=(1,), padding=[(CONV_WIDTH - 1, 0)],
        dimension_numbers=('NWC', 'WIO', 'NWC'), feature_group_count=D_MODEL)
    return (bgate * u) @ w_out


def t5_bucket(n):
    max_exact = NUM_BUCKETS // 2
    nf = jnp.maximum(n, 1).astype(jnp.float32)
    large = max_exact + (jnp.log(nf / max_exact) / math.log(MAX_DISTANCE / max_exact)
                         * (NUM_BUCKETS - max_exact)).astype(jnp.int32)
    large = jnp.minimum(large, NUM_BUCKETS - 1)
    return jnp.where(n < max_exact, n, large)


def dilated_window_attention(q, k, v, window, dilation, bias_table):
    b, s, h, hd = q.shape
    n_keys = window // dilation
    sub_len = s // dilation
    nb = -(-sub_len // BLOCK)
    lp = nb * BLOCK

    def to_sub(t):
        return t.reshape(b, sub_len, dilation, h, hd).transpose(0, 2, 1, 3, 4)

    qb = jnp.pad(to_sub(q), ((0, 0), (0, 0), (0, lp - sub_len), (0, 0), (0, 0)))
    qb = qb.reshape(b, dilation, nb, BLOCK, h, hd)

    def windows(t):
        tp = jnp.pad(to_sub(t), ((0, 0), (0, 0), (BLOCK, lp - sub_len), (0, 0), (0, 0)))
        tp = tp.reshape(b, dilation, nb + 1, BLOCK, h, hd)
        return jnp.concatenate([tp[:, :, :-1], tp[:, :, 1:]], axis=3)

    kw = windows(k)
    vw = windows(v)
    qi = jnp.arange(BLOCK)[:, None]
    kj = jnp.arange(2 * BLOCK)[None, :]
    dist = BLOCK + qi - kj
    bucket = t5_bucket(jnp.maximum(dist, 0) * dilation)
    bias = bias_table[bucket].astype(jnp.float32).transpose(2, 0, 1)
    key_idx = (jnp.arange(nb)[:, None, None] - 1) * BLOCK + kj[None]
    valid = (dist >= 0) & (dist <= n_keys) & (key_idx >= 0)

    scores = jnp.einsum('brnqhd,brnkhd->brhnqk', qb, kw).astype(jnp.float32) * (HEAD_DIM ** -0.5)
    scores = jnp.where(valid, scores + bias[:, None], NEG_INF)
    lse = jax.nn.logsumexp(scores, axis=-1)
    p = jnp.exp(scores - lse[..., None])
    out = jnp.einsum('brhnqk,brnkhd->brnqhd', p.astype(vw.dtype), vw)
    out = out.reshape(b, dilation, lp, h, hd)[:, :, :sub_len]
    out = out.transpose(0, 2, 1, 3, 4).reshape(b, s, h, hd)
    lse = lse.transpose(0, 1, 3, 4, 2).reshape(b, dilation, lp, h)[:, :, :sub_len]
    lse = lse.transpose(0, 2, 1, 3).reshape(b, s, h)
    return out, lse


def shared_kv(x, cond, kv_ada_w, kv_ada_b, w_kv):
    b, s, _ = x.shape
    shift, scale = jnp.split(cond @ kv_ada_w + kv_ada_b, 2, axis=-1)
    kv = (modulate(x, shift, scale) @ w_kv).reshape(b, s, 2, N_ATTN_GROUPS, HEADS_PER_GROUP, HEAD_DIM)
    return kv[:, :, 0], kv[:, :, 1]


def dilated_attention_mixer(h, k_sh, v_sh, w_q, w_o, rel_bias):
    b, s, _ = h.shape
    q = (h @ w_q).reshape(b, s, N_ATTN_GROUPS, HEADS_PER_GROUP, HEAD_DIM)
    outs = []
    lses = []
    for g, (window, dil) in enumerate(DIL_GROUPS):
        o, l = dilated_window_attention(
            q[:, :, g], k_sh[:, :, g], v_sh[:, :, g], window, dil,
            rel_bias[:, g * HEADS_PER_GROUP:(g + 1) * HEADS_PER_GROUP])
        outs.append(o)
        lses.append(l)
    out = jnp.stack(outs, axis=2)
    lse = jnp.stack(lses, axis=2)
    wts = jax.nn.softmax(lse, axis=2)
    mixed = jnp.sum(wts[..., None] * out.astype(jnp.float32), axis=2).astype(h.dtype)
    return mixed.reshape(b, s, ATTN_GROUP_WIDTH) @ w_o


def grouped_moe(h, router_w, router_bias, w_gate, w_up, w_down):
    b, s, _ = h.shape
    aff = jax.nn.sigmoid((h @ router_w).astype(jnp.float32))
    sel = aff + router_bias.astype(jnp.float32)
    group_score = lax.top_k(sel.reshape(b, s, N_EXPERT_GROUPS, EXPERTS_PER_GROUP), TOP_K)[0].sum(-1)
    best_group = jnp.argmax(group_score, axis=-1)
    expert_group = jnp.arange(N_EXPERTS) // EXPERTS_PER_GROUP
    masked = jnp.where(expert_group == best_group[..., None], sel, NEG_INF)
    _, idx = lax.top_k(masked, TOP_K)
    w_sel = jnp.take_along_axis(aff, idx, axis=-1)
    w_sel = w_sel / jnp.sum(w_sel, axis=-1, keepdims=True)
    combine = jnp.sum(jax.nn.one_hot(idx, N_EXPERTS, dtype=jnp.float32) * w_sel[..., None], axis=-2)
    y = jnp.zeros(h.shape, jnp.float32)
    for e in range(N_EXPERTS):
        he = jax.nn.silu(h @ w_gate[e]) * (h @ w_up[e])
        y = y + combine[..., e:e + 1] * (he @ w_down[e]).astype(jnp.float32)
    return y.astype(h.dtype)


def setup_inputs(seed: int = 0) -> dict:
    key = jax.random.key(seed)
    ks = jax.random.split(key, 20)

    def nrm(k, shape, scale):
        return jax.random.normal(k, shape, jnp.float32) * scale

    d = D_MODEL
    conv_col_scale = jnp.concatenate([jnp.ones((2 * d,), jnp.float32), jnp.full((d,), BETA, jnp.float32)])
    kv_col_scale = jnp.concatenate([jnp.ones((Q_WIDTH,), jnp.float32), jnp.full((Q_WIDTH,), BETA, jnp.float32)])
    return {
        'x': nrm(ks[0], (BATCH, SEQ, d), 1.0),
        'c': nrm(ks[1], (BATCH, d), 1.0),
        'ada_w': nrm(ks[2], (DEPTH, d, 6 * d), 0.5 * d ** -0.5),
        'ada_b': nrm(ks[3], (DEPTH, 6 * d), 0.02),
        'ln_g': 1.0 + nrm(ks[4], (DEPTH, 2, d), 0.02),
        'ln_b': nrm(ks[5], (DEPTH, 2, d), 0.02),
        'conv_w_in': nrm(ks[6], (N_A_LAYERS, d, 3 * d), d ** -0.5) * conv_col_scale,
        'conv_w': nrm(ks[7], (N_A_LAYERS, CONV_WIDTH, d), CONV_WIDTH ** -0.5),
        'conv_w_out': nrm(ks[8], (N_A_LAYERS, d, d), BETA * d ** -0.5),
        'kv_ada_w': nrm(ks[9], (d, 2 * d), 0.5 * d ** -0.5),
        'kv_ada_b': nrm(ks[10], (2 * d,), 0.02),
        'w_kv': nrm(ks[11], (d, 2 * Q_WIDTH), d ** -0.5) * kv_col_scale,
        'attn_w_q': nrm(ks[12], (N_B_LAYERS, d, Q_WIDTH), d ** -0.5),
        'attn_w_o': nrm(ks[13], (N_B_LAYERS, ATTN_GROUP_WIDTH, d), BETA * ATTN_GROUP_WIDTH ** -0.5),
        'rel_bias': nrm(ks[14], (NUM_BUCKETS, N_ATTN_HEADS), 0.2),
        'router_w': nrm(ks[15], (d, N_EXPERTS), d ** -0.5),
        'router_bias': nrm(ks[16], (N_EXPERTS,), 0.01),
        'moe_w_gate': nrm(ks[17], (DEPTH, N_EXPERTS, d, EXPERT_FF), d ** -0.5),
        'moe_w_up': nrm(ks[18], (DEPTH, N_EXPERTS, d, EXPERT_FF), BETA * d ** -0.5),
        'moe_w_down': nrm(ks[19], (DEPTH, N_EXPERTS, EXPERT_FF, d), BETA * EXPERT_FF ** -0.5),
    }


def reference(x, c, ada_w, ada_b, ln_g, ln_b, conv_w_in, conv_w, conv_w_out, kv_ada_w, kv_ada_b,
              w_kv, attn_w_q, attn_w_o, rel_bias, router_w, router_bias, moe_w_gate, moe_w_up,
              moe_w_down):
    cond = jax.nn.silu(c)
    k_sh = None
    v_sh = None
    for layer in range(DEPTH):
        sh1, sc1, g1, sh2, sc2, g2 = jnp.split(cond @ ada_w[layer] + ada_b[layer], 6, axis=-1)
        h = modulate(x, sh1, sc1)
        if layer < N_A_LAYERS:
            y = short_conv_mixer(h, conv_w_in[layer], conv_w[layer], conv_w_out[layer])
        else:
            if layer == N_A_LAYERS:
                k_sh, v_sh = shared_kv(x, cond, kv_ada_w, kv_ada_b, w_kv)
            j = layer - N_A_LAYERS
            y = dilated_attention_mixer(h, k_sh, v_sh, attn_w_q[j], attn_w_o[j], rel_bias)
        x = layer_norm(ALPHA * x + (1 + g1[:, None, :]) * y, ln_g[layer, 0], ln_b[layer, 0])
        h = modulate(x, sh2, sc2)
        y = grouped_moe(h, router_w, router_bias, moe_w_gate[layer], moe_w_up[layer], moe_w_down[layer])
        x = layer_norm(ALPHA * x + (1 + g2[:, None, :]) * y, ln_g[layer, 1], ln_b[layer, 1])
    return x
```

```cpp
#include <hip/hip_runtime.h>
#include <cstdio>
#include <cstdint>
namespace pg8 {
#define PG8_LAS __attribute__((address_space(3)))
typedef unsigned short bf16_t;
typedef short bf16x8 __attribute__((ext_vector_type(8)));
typedef float f32x4 __attribute__((ext_vector_type(4)));
typedef unsigned u32x4 __attribute__((ext_vector_type(4)));
constexpr int BM = 256, BK = 64, HALF = 128, HTB = HALF * BK * 2  , STAGE_BYTES = 8 * HTB, NXCD = 8, WGM = 8;

__host__ __device__ __forceinline__ int lds_byte(int r, int c) { const int st = (r >> 4) * 2 + (c >> 5), rr = r & 15, cc = c & 31, ob = rr * 64 + cc * 2; return st * 1024 + (ob ^ (((ob >> 9) & 1) << 5)); }
__host__ __device__ __forceinline__ void stage_rc(int b, int& R, int& C) { const int st = b / 1024, sb = b % 1024, swz = sb ^ (((sb >> 9) & 1) << 5); R = (st >> 1) * 16 + swz / 64; C = (st & 1) * 32 + (swz % 64) / 2; }
__host__ __device__ __forceinline__ int perm32(int rho) { const int n = rho >> 4, i = rho & 15; return 8 * (i >> 2) + 4 * n + (i & 3); }

struct Unit { int pm, pn; };
struct Gemm { const bf16_t* A; const bf16_t* Bt; int M, N, K; };

struct StaticOrder {
    int nM, nN, nwg, G, c;
    __host__ __device__ void init(int M, int N, int G_, int c_) { nM = M / BM; nN = N / BM; nwg = nM * nN; G = G_; c = c_; }
    __host__ __device__ bool next(int i, Unit& u) const {
        const long L = (long)i * G + c; if (L >= nwg) return false;
        int wgid = (int)L; { const int q = nwg / NXCD, r = nwg % NXCD, xcd = wgid % NXCD, off = wgid / NXCD; wgid = (xcd < r ? xcd * (q + 1) : r * (q + 1) + (xcd - r) * q) + off; }
        const int nig = WGM * nN, gid = wgid / nig, fm = gid * WGM, gsz = (nM - fm) < WGM ? (nM - fm) : WGM;
        u.pm = fm + ((wgid % nig) % gsz); u.pn = (wgid % nig) / gsz; return true;
    }
    __device__ __forceinline__ void a_ready(const Unit&) const {}
    __device__ __forceinline__ void done(const Unit&) const {}
};

__device__ __forceinline__ unsigned cvt_pk_bf16(float lo, float hi) { unsigned r; asm volatile("v_cvt_pk_bf16_f32 %0, %1, %2" : "=v"(r) : "v"(lo), "v"(hi)); return r; }
typedef float f32x2 __attribute__((ext_vector_type(2)));
__device__ __forceinline__ f32x2 gelu_pk(f32x2 v) {
    const f32x2 av = __builtin_elementwise_abs(v), d = av * 0.2316418882f + 1.0f;
    f32x2 t; t.x = __builtin_amdgcn_rcpf(d.x); t.y = __builtin_amdgcn_rcpf(d.y);
    f32x2 q = t * 0.5307027145f + (-0.7265760135f); q = q * t + 0.7107068705f; q = q * t + (-0.142248368f); q = q * t + 0.127414796f; q = q * t;
    const f32x2 s = (v * v) * (-0.72134752044f);
    f32x2 e; e.x = __builtin_amdgcn_exp2f(s.x); e.y = __builtin_amdgcn_exp2f(s.y);
    const f32x2 m = v * (q * e), r = v - m;
    f32x2 o; o.x = v.x < 0.f ? m.x : r.x; o.y = v.y < 0.f ? m.y : r.y; return o;
}

template <int ACT  > struct EpiBf16 {
    static constexpr bool PERM = true, AFTER_DRAIN = false; static_assert(ACT == 0 || ACT == 1, "EpiBf16: ACT is 0 (none) or 1 (gelu_pk)");
    bf16_t* O; int ldc; const float* bias; int split_cols; size_t split_stride; float scale0;
    __device__ __forceinline__ void operator()(const f32x4 (&acc)[2][2][4][2], const Unit& u, int wr, int wc, int fr, int fq) const {
        const int row0 = u.pm * BM + wr * 64 + fr; int colt = u.pn * BM; bf16_t* base = O;
        float sc = 1.f; if (split_cols) { const int t = colt / split_cols; base += (size_t)t * split_stride; colt -= t * split_cols; if (t == 0) sc = scale0; }
        const int col0 = colt + wc * 32 + 8 * fq, bcol0 = u.pn * BM + wc * 32 + 8 * fq;
        f32x4 bv[2][2];
#pragma unroll
        for (int bj = 0; bj < 2; ++bj)
#pragma unroll
            for (int n = 0; n < 2; ++n) bv[bj][n] = bias ? *(const f32x4*)(bias + bcol0 + bj * HALF + 4 * n) : (f32x4){0.f, 0.f, 0.f, 0.f};
#pragma unroll
        for (int ai = 0; ai < 2; ++ai)
#pragma unroll
            for (int m = 0; m < 4; ++m) { bf16_t* rowp = base + (size_t)(row0 + ai * HALF + m * 16) * ldc + col0;
#pragma unroll
                for (int bj = 0; bj < 2; ++bj) { f32x4 v0 = acc[ai][bj][m][0] + bv[bj][0], v1 = acc[ai][bj][m][1] + bv[bj][1];
                    if (ACT == 1) { f32x2 a = gelu_pk((f32x2){v0[0], v0[1]}), b = gelu_pk((f32x2){v0[2], v0[3]}), c = gelu_pk((f32x2){v1[0], v1[1]}), d = gelu_pk((f32x2){v1[2], v1[3]});
                        v0 = (f32x4){a.x, a.y, b.x, b.y}; v1 = (f32x4){c.x, c.y, d.x, d.y}; }
                    v0 = v0 * sc; v1 = v1 * sc; u32x4 w; w.x = cvt_pk_bf16(v0[0], v0[1]); w.y = cvt_pk_bf16(v0[2], v0[3]); w.z = cvt_pk_bf16(v1[0], v1[1]); w.w = cvt_pk_bf16(v1[2], v1[3]);
                    *(u32x4*)(rowp + bj * HALF) = w; } }
    }
};
__device__ __forceinline__ u32x4 pack8(const f32x4 v0, const f32x4 v1) { u32x4 w; w.x = cvt_pk_bf16(v0[0], v0[1]); w.y = cvt_pk_bf16(v0[2], v0[3]); w.z = cvt_pk_bf16(v1[0], v1[1]); w.w = cvt_pk_bf16(v1[2], v1[3]); return w; }
struct EpiCV {
    static constexpr bool PERM = true, AFTER_DRAIN = false;
    bf16_t* U; bf16_t* BG;
    __device__ __forceinline__ void operator()(const f32x4 (&acc)[2][2][4][2], const Unit& u, int wr, int wc, int fr, int fq) const {
        const int row0 = u.pm * BM + wr * 64 + fr;
        if (u.pn < 8) {
            const int col0 = u.pn * 128 + wc * 32 + 8 * fq;
#pragma unroll
            for (int ai = 0; ai < 2; ++ai)
#pragma unroll
                for (int m = 0; m < 4; ++m) { bf16_t* rowp = U + (size_t)(row0 + ai * HALF + m * 16) * 1024 + col0;
                    *(u32x4*)rowp = pack8(acc[ai][0][m][0] * acc[ai][1][m][0], acc[ai][0][m][1] * acc[ai][1][m][1]); }
        } else {
            const int col0 = (u.pn - 8) * 256 + wc * 32 + 8 * fq;
#pragma unroll
            for (int ai = 0; ai < 2; ++ai)
#pragma unroll
                for (int m = 0; m < 4; ++m) { bf16_t* rowp = BG + (size_t)(row0 + ai * HALF + m * 16) * 1024 + col0;
#pragma unroll
                    for (int bj = 0; bj < 2; ++bj) *(u32x4*)(rowp + bj * HALF) = pack8(acc[ai][bj][m][0], acc[ai][bj][m][1]); }
        }
    }
};
struct EpiRes {
    static constexpr bool PERM = false, AFTER_DRAIN = false;
    const float* xin; float* out; const float* gate; int gstride; int rows_per_batch; float alpha;
    __device__ __forceinline__ void operator()(const f32x4 (&acc)[2][2][4][2], const Unit& u, int wr, int wc, int fr, int fq) const {
        const int row0 = u.pm * BM + wr * 64 + fr, col0 = u.pn * BM + wc * 32 + 4 * fq;
        const int b = (u.pm * BM) / rows_per_batch;
        const float* gp = gate + (size_t)b * gstride + col0;
        const unsigned off0 = (unsigned)row0 * 1024u + (unsigned)col0;
#pragma unroll
        for (int bj = 0; bj < 2; ++bj)
#pragma unroll
            for (int n = 0; n < 2; ++n) { const f32x4 gv = *(const f32x4*)(gp + bj * HALF + n * 16) + 1.0f;
#pragma unroll
                for (int ai = 0; ai < 2; ++ai)
#pragma unroll
                    for (int m = 0; m < 4; ++m) { const unsigned off = off0 + (unsigned)((ai * HALF + m * 16) * 1024 + bj * HALF + n * 16);
                        const f32x4 xv = *(const f32x4*)(xin + off);
                        *(f32x4*)(out + off) = xv * alpha + gv * acc[ai][bj][m][n]; }
                asm volatile("" ::: "memory"); }
    }
};
__device__ __forceinline__ float silu_f(float x) { return x * __builtin_amdgcn_rcpf(1.0f + __builtin_amdgcn_exp2f(-1.4426950408889634f * x)); }
struct EpiMoeUp {
    static constexpr bool PERM = true, AFTER_DRAIN = false;
    bf16_t* HE;
    __device__ __forceinline__ void operator()(const f32x4 (&acc)[2][2][4][2], const Unit& u, int wr, int wc, int fr, int fq) const {
        const int row0 = u.pm * BM + wr * 64 + fr, col0 = (u.pn & 1) * 128 + wc * 32 + 8 * fq;
#pragma unroll
        for (int ai = 0; ai < 2; ++ai)
#pragma unroll
            for (int m = 0; m < 4; ++m) { f32x4 h0, h1;
#pragma unroll
                for (int j = 0; j < 4; ++j) { h0[j] = silu_f(acc[ai][0][m][0][j]) * acc[ai][1][m][0][j]; h1[j] = silu_f(acc[ai][0][m][1][j]) * acc[ai][1][m][1][j]; }
                *(u32x4*)(HE + (size_t)(row0 + ai * HALF + m * 16) * 256 + col0) = pack8(h0, h1); }
    }
};
struct EpiMoeDown {
    static constexpr bool PERM = true, AFTER_DRAIN = false;
    const int* slotp; const float* slotw; bf16_t* Y2;
    __device__ __forceinline__ void operator()(const f32x4 (&acc)[2][2][4][2], const Unit& u, int wr, int wc, int fr, int fq) const {
        const int row0 = u.pm * BM + wr * 64 + fr, col0 = (u.pn & 3) * 256 + wc * 32 + 8 * fq;
#pragma unroll
        for (int ai = 0; ai < 2; ++ai)
#pragma unroll
            for (int m = 0; m < 4; ++m) { const int slot = row0 + ai * HALF + m * 16; const int pair = slotp[slot]; const float w = slotw[slot];
                if (pair >= 0) { const unsigned off = (unsigned)pair * 1024u + (unsigned)col0;
#pragma unroll
                    for (int bj = 0; bj < 2; ++bj) *(u32x4*)(Y2 + off + bj * HALF) = pack8(acc[ai][bj][m][0] * w, acc[ai][bj][m][1] * w); }
                if (m & 1) asm volatile("" ::: "memory"); }
    }
};
struct MoeSched {
    const int* te; int ntiles; int nNt; int G, c;
    __device__ __forceinline__ bool next(int i, Unit& u) const {
        const long L = (long)i * G + c; if (L >= (long)ntiles * nNt) return false;
        const int T = (int)(L / nNt), q = (int)(L % nNt);
        const int e = __builtin_amdgcn_readfirstlane(te[T]);
        u.pm = T; u.pn = e * nNt + q; return true;
    }
    __device__ __forceinline__ void a_ready(const Unit&) const {}
    __device__ __forceinline__ void done(const Unit&) const {}
};

template <class Epi, class Sched, bool ALIGN_EPI = false, bool SP2 = false>
__device__ __forceinline__ void gemm_phase(PG8_LAS unsigned char* lds, const Gemm g, const Sched& S, const Epi& E) {
    const int tid = threadIdx.x, wid = __builtin_amdgcn_readfirstlane(tid >> 6), lane = tid & 63, wr = wid >> 2, wc = wid & 3, fr = lane & 15, fq = lane >> 4;
    const int K = g.K, nt = K / BK;
    unsigned voffA[2], voffB[2];
#pragma unroll
    for (int i = 0; i < 2; ++i) { int R, C; stage_rc(tid * 16 + i * 8192, R, C); const int Rb = Epi::PERM ? ((R & ~31) + perm32(R & 31)) : R;
        voffA[i] = (unsigned)(R * K + C) * 2u; voffB[i] = (unsigned)(Rb * K + C) * 2u; }
    const size_t kstep = (size_t)(BK * 2);
    const size_t hstep = (size_t)HALF * K * 2;
    const size_t tstep = 2 * hstep;
    const unsigned ldsw = (unsigned)wid * 1024u;
    const int aoff = lds_byte(wr * 64 + fr, fq * 8), boff = lds_byte(wc * 32 + fr, fq * 8);
#define PG8_SA(b, h) (((b) * 2 + (h)) * HTB)
#define PG8_SB(b, h) ((4 + (b) * 2 + (h)) * HTB)
#define PG8_STAGE(bufoff, gbase, voff) do { _Pragma("unroll") for (int _i = 0; _i < 2; ++_i) \
        __builtin_amdgcn_global_load_lds((const unsigned*)((const char*)(gbase) + (voff)[_i]), (PG8_LAS unsigned*)(lds + (bufoff) + ldsw + _i * 8192), 16, 0, 0); } while (0)
#define PG8_LDA(dst, b, h) do { _Pragma("unroll") for (int m = 0; m < 4; ++m) _Pragma("unroll") for (int k = 0; k < 2; ++k) dst[m][k] = *(const PG8_LAS bf16x8*)(lds + PG8_SA(b, h) + aoff + m * 2048 + k * 1024); } while (0)
#define PG8_LDB(dst, b, h) do { _Pragma("unroll") for (int n = 0; n < 2; ++n) _Pragma("unroll") for (int k = 0; k < 2; ++k) dst[n][k] = *(const PG8_LAS bf16x8*)(lds + PG8_SB(b, h) + boff + n * 2048 + k * 1024); } while (0)
#define PG8_MMA(ai, bj, At, Bt) do { __builtin_amdgcn_s_setprio(1); _Pragma("unroll") for (int m = 0; m < 4; ++m) _Pragma("unroll") for (int n = 0; n < 2; ++n) _Pragma("unroll") for (int k = 0; k < 2; ++k) \
        acc[ai][bj][m][n] = __builtin_amdgcn_mfma_f32_16x16x32_bf16(Bt[n][k], At[m][k], acc[ai][bj][m][n], 0, 0, 0); __builtin_amdgcn_s_setprio(0); } while (0)
#define PG8_WAIT_V(n) asm volatile("s_waitcnt vmcnt(" #n ")" ::: "memory")
#define PG8_WAIT_L(n) asm volatile("s_waitcnt lgkmcnt(" #n ")" ::: "memory")
#define PG8_BAR __builtin_amdgcn_s_barrier()
#define PG8_SCHED __builtin_amdgcn_sched_barrier(0)
    Unit cur, nxt; int ui = 0;
    if (!S.next(0, cur)) return;
    f32x4 acc[2][2][4][2];
#pragma unroll
    for (int a = 0; a < 2; ++a)
#pragma unroll
        for (int b = 0; b < 2; ++b)
#pragma unroll
            for (int m = 0; m < 4; ++m)
#pragma unroll
                for (int n = 0; n < 2; ++n) acc[a][b][m][n] = (f32x4){0.f, 0.f, 0.f, 0.f};
    bf16x8 At[4][2], B0[2][2], B1[2][2];
    const char* cA = (const char*)g.A + (size_t)cur.pm * tstep; const char* cB = (const char*)g.Bt + (size_t)cur.pn * tstep;
    S.a_ready(cur);
    if constexpr (SP2) {
        PG8_STAGE(PG8_SB(0, 0), cB, voffB); PG8_STAGE(PG8_SB(0, 1), cB + hstep, voffB); PG8_STAGE(PG8_SA(0, 0), cA, voffA); PG8_STAGE(PG8_SA(0, 1), cA + hstep, voffA);
        if (wr == 1) PG8_BAR;
        PG8_WAIT_V(2); PG8_BAR;
        PG8_STAGE(PG8_SB(1, 0), cB + kstep, voffB); PG8_STAGE(PG8_SA(1, 0), cA + kstep, voffA); PG8_STAGE(PG8_SB(1, 1), cB + hstep + kstep, voffB);
        PG8_WAIT_V(6); PG8_BAR;
    } else {
        PG8_STAGE(PG8_SB(0, 0), cB, voffB); PG8_STAGE(PG8_SA(0, 0), cA, voffA); PG8_STAGE(PG8_SB(0, 1), cB + hstep, voffB); PG8_STAGE(PG8_SA(0, 1), cA + hstep, voffA);
        if (wr == 1) PG8_BAR;
        PG8_WAIT_V(4); PG8_BAR;
        PG8_STAGE(PG8_SB(1, 0), cB + kstep, voffB); PG8_STAGE(PG8_SA(1, 0), cA + kstep, voffA); PG8_STAGE(PG8_SB(1, 1), cB + hstep + kstep, voffB);
        PG8_WAIT_V(6); PG8_BAR;
    }
    for (;;) {
        const bool has_next = S.next(ui + 1, nxt);
        const char* nA = has_next ? (const char*)g.A + (size_t)nxt.pm * tstep : cA; const char* nB = has_next ? (const char*)g.Bt + (size_t)nxt.pn * tstep : cB;
        for (int t = 0; t < nt; t += 2) {
            const bool last = (t == nt - 2);
            const char* a1 = cA + (size_t)(t + 1) * kstep;
            const char* a2 = last ? nA : cA + (size_t)(t + 2) * kstep; const char* b2 = last ? nB : cB + (size_t)(t + 2) * kstep;
            const char* a3 = a2 + kstep; const char* b3 = b2 + kstep;
            if (last && has_next) S.a_ready(nxt);
            if constexpr (SP2) {
            PG8_LDB(B0, 0, 0); PG8_LDB(B1, 0, 1); PG8_SCHED; PG8_LDA(At, 0, 0); PG8_STAGE(PG8_SA(1, 1), a1 + hstep, voffA);
            PG8_WAIT_V(8); PG8_WAIT_L(0); PG8_BAR; PG8_MMA(0, 0, At, B0); PG8_MMA(0, 1, At, B1); PG8_BAR; PG8_SCHED;
            PG8_LDA(At, 0, 1); PG8_STAGE(PG8_SB(0, 0), b2, voffB); PG8_STAGE(PG8_SB(0, 1), b2 + hstep, voffB); PG8_STAGE(PG8_SA(0, 0), a2, voffA);
            PG8_WAIT_V(8); PG8_WAIT_L(0); PG8_BAR; PG8_MMA(1, 0, At, B0); PG8_MMA(1, 1, At, B1); PG8_BAR; PG8_SCHED;
            PG8_LDB(B0, 1, 0); PG8_LDB(B1, 1, 1); PG8_SCHED; PG8_LDA(At, 1, 0); PG8_STAGE(PG8_SA(0, 1), a2 + hstep, voffA);
            PG8_WAIT_V(8); PG8_WAIT_L(0); PG8_BAR; PG8_MMA(0, 0, At, B0); PG8_MMA(0, 1, At, B1); PG8_BAR; PG8_SCHED;
            PG8_LDA(At, 1, 1); PG8_STAGE(PG8_SB(1, 0), b3, voffB); PG8_STAGE(PG8_SB(1, 1), b3 + hstep, voffB); PG8_STAGE(PG8_SA(1, 0), a3, voffA);
            PG8_WAIT_V(8); PG8_WAIT_L(0); PG8_BAR; PG8_MMA(1, 0, At, B0); PG8_MMA(1, 1, At, B1); PG8_BAR; PG8_SCHED;
            } else {
            PG8_LDB(B0, 0, 0); PG8_SCHED; PG8_LDA(At, 0, 0); PG8_STAGE(PG8_SA(1, 1), a1 + hstep, voffA);
            PG8_WAIT_L(8); PG8_BAR; PG8_WAIT_L(0); PG8_MMA(0, 0, At, B0); PG8_BAR; PG8_SCHED;
            PG8_LDB(B1, 0, 1); PG8_STAGE(PG8_SB(0, 0), b2, voffB);
            PG8_BAR; PG8_WAIT_L(0); PG8_MMA(0, 1, At, B1); PG8_BAR;
            PG8_LDA(At, 0, 1); PG8_STAGE(PG8_SA(0, 0), a2, voffA);
            PG8_BAR; PG8_WAIT_L(0); PG8_MMA(1, 0, At, B0); PG8_BAR; PG8_SCHED;
            PG8_STAGE(PG8_SB(0, 1), b2 + hstep, voffB);
            PG8_WAIT_V(6); PG8_BAR; PG8_MMA(1, 1, At, B1); PG8_BAR;
            PG8_LDB(B0, 1, 0); PG8_SCHED; PG8_LDA(At, 1, 0); PG8_STAGE(PG8_SA(0, 1), a2 + hstep, voffA);
            PG8_WAIT_L(8); PG8_BAR; PG8_WAIT_L(0); PG8_MMA(0, 0, At, B0); PG8_BAR; PG8_SCHED;
            PG8_LDB(B1, 1, 1); PG8_STAGE(PG8_SB(1, 0), b3, voffB);
            PG8_BAR; PG8_WAIT_L(0); PG8_MMA(0, 1, At, B1); PG8_BAR;
            PG8_LDA(At, 1, 1); PG8_STAGE(PG8_SA(1, 0), a3, voffA);
            PG8_BAR; PG8_WAIT_L(0); PG8_MMA(1, 0, At, B0); PG8_BAR; PG8_SCHED;
            PG8_STAGE(PG8_SB(1, 1), b3 + hstep, voffB);
            PG8_WAIT_V(6); PG8_BAR; PG8_MMA(1, 1, At, B1); PG8_BAR;
            }
        }
        if constexpr (ALIGN_EPI) { if (wr == 0) PG8_BAR; }
        if constexpr (!Epi::AFTER_DRAIN) { E(acc, cur, wr, wc, fr, fq); S.done(cur); }
        if (!has_next) break;
#pragma unroll
        for (int a = 0; a < 2; ++a)
#pragma unroll
            for (int b = 0; b < 2; ++b)
#pragma unroll
                for (int m = 0; m < 4; ++m)
#pragma unroll
                    for (int n = 0; n < 2; ++n) acc[a][b][m][n] = (f32x4){0.f, 0.f, 0.f, 0.f};
        cur = nxt; cA = nA; cB = nB; ++ui;
        if constexpr (ALIGN_EPI) { if (wr == 1) PG8_BAR; }
    }
    PG8_WAIT_V(0);
    if constexpr (!ALIGN_EPI) { if (wr == 0) PG8_BAR; }
    PG8_BAR;
    if constexpr (Epi::AFTER_DRAIN) { E.fused(acc, cur, wr, wc, fr, fq, lds, wid, lane); S.done(cur); }
#undef PG8_SA
#undef PG8_SB
#undef PG8_STAGE
#undef PG8_LDA
#undef PG8_LDB
#undef PG8_MMA
#undef PG8_WAIT_V
#undef PG8_WAIT_L
#undef PG8_BAR
#undef PG8_SCHED
}
}
#define GAS __attribute__((address_space(1)))
#define LAS __attribute__((address_space(3)))
typedef unsigned short bf16;
typedef unsigned v4u __attribute__((ext_vector_type(4)));
typedef float f32x4 __attribute__((ext_vector_type(4)));
typedef short bf16x8 __attribute__((ext_vector_type(8)));
typedef GAS unsigned gu32;
typedef GAS unsigned long long gu64;
#define RLX_AGENT __ATOMIC_RELAXED, __HIP_MEMORY_SCOPE_AGENT
#define LDS_WAIT() asm volatile("s_waitcnt lgkmcnt(0)" ::: "memory")
#define VM_WAIT() asm volatile("s_waitcnt vmcnt(0)" ::: "memory")
__device__ __forceinline__ unsigned long long rt() { return __builtin_amdgcn_s_memrealtime(); }
__device__ __forceinline__ unsigned f2bf(float f) { unsigned u = __builtin_bit_cast(unsigned, f); return (u + 0x7fffu + ((u >> 16) & 1u)) >> 16; }
__device__ __forceinline__ unsigned pk2(float lo, float hi) { return f2bf(lo) | (f2bf(hi) << 16); }

#define XB_TMO      128
#define XB_XCNT(j)  (256  + 64 * (j))
#define XB_XSUB(j)  (1280 + 64 * (j))
#define XB_XGEN(j)  (2304 + 64 * (j))
#define XB_TOP      3328
#define XB_TOPGEN   3392
#define XCD_BAR_WORDS 3456
#define XB_SPIN_CAP (1u << 18)

__device__ __forceinline__ unsigned xb_ld(unsigned* p)              { return __hip_atomic_load(p, __ATOMIC_RELAXED, __HIP_MEMORY_SCOPE_AGENT); }
__device__ __forceinline__ unsigned xb_add(unsigned* p, unsigned v) { return __hip_atomic_fetch_add(p, v, __ATOMIC_RELAXED, __HIP_MEMORY_SCOPE_AGENT); }
__device__ __forceinline__ unsigned xb_xcc_id() { return (unsigned)__builtin_amdgcn_s_getreg((3 << 11) | 20) & 0xFu; }
#define XB_SPIN(cond, bar) do { unsigned _sp = 0; while (cond) { __builtin_amdgcn_s_sleep(1); \
    if ((++_sp & 255u) == 0u) { if (xb_ld(&(bar)[XB_TMO])) break; if (_sp > XB_SPIN_CAP) { atomicAdd(&(bar)[XB_TMO], 1u); break; } } } } while (0)

struct XcdBarrier {
    unsigned* bar; unsigned x;
    volatile LAS unsigned* st;
};

__device__ __forceinline__ XcdBarrier xcd_barrier_post(unsigned* bar, volatile LAS unsigned* st) {
    XcdBarrier b; b.bar = bar; b.x = xb_xcc_id(); b.st = st;
    if (threadIdx.x == 0) (void)xb_add(&bar[XB_XCNT(b.x)], 1u);
    return b;
}
__device__ __forceinline__ void xcd_barrier_complete(unsigned* bar, unsigned x, unsigned& nloc, unsigned& nx) {
    const unsigned G = gridDim.x * gridDim.y * gridDim.z;
    unsigned sum, cnt, mine, sp = 0u;
    for (;;) {
        sum = 0u; cnt = 0u; mine = 0u;
#pragma unroll
        for (unsigned j = 0; j < 16; ++j) { const unsigned c = xb_ld(&bar[XB_XCNT(j)]); sum += c; cnt += (c > 0u) ? 1u : 0u; mine = (j == x) ? c : mine; }
        if (sum == G) break;
        __builtin_amdgcn_s_sleep(1);
        if ((++sp & 255u) == 0u) { if (xb_ld(&bar[XB_TMO])) break; if (sp > XB_SPIN_CAP) { atomicAdd(&bar[XB_TMO], 1u); break; } }
    }
    nloc = mine > 0u ? mine : 1u; nx = cnt > 0u ? cnt : 1u;
}

__device__ __forceinline__ void xcd_barrier(const XcdBarrier& b) {
    asm volatile("s_waitcnt vmcnt(0)" ::: "memory");
    __syncthreads();
    if (threadIdx.x == 0) {
        unsigned* bar = b.bar;
        __builtin_amdgcn_s_waitcnt(0);
        unsigned nloc = b.st[0], nx = b.st[1];
        if (nloc == 0u) { xcd_barrier_complete(bar, b.x, nloc, nx); b.st[0] = nloc; b.st[1] = nx; }
        const unsigned old = xb_add(&bar[XB_XSUB(b.x)], 1u);
        const unsigned gen = old / nloc;
        if (old + 1u == (gen + 1u) * nloc) {
            __builtin_amdgcn_fence(__ATOMIC_RELEASE, "agent");
            asm volatile("s_waitcnt vmcnt(0)" ::: "memory");
            const unsigned og = xb_add(&bar[XB_TOP], 1u);
            const unsigned tg = og / nx;
            if (og + 1u == (tg + 1u) * nx) xb_add(&bar[XB_TOPGEN], 1u);
            else XB_SPIN(xb_ld(&bar[XB_TOPGEN]) == tg, bar);
            __builtin_amdgcn_fence(__ATOMIC_ACQUIRE, "agent");
            xb_add(&bar[XB_XGEN(b.x)], 1u);
            asm volatile("s_waitcnt vmcnt(0)" ::: "memory");
        } else {
            XB_SPIN(xb_ld(&bar[XB_XGEN(b.x)]) == gen, bar);
            __builtin_amdgcn_fence(__ATOMIC_ACQUIRE, "agent");
            asm volatile("s_waitcnt vmcnt(0)" ::: "memory");
        }
    }
    __syncthreads();
}

constexpr int NWAVES = 8;
constexpr int NPHASE = 22;
#ifndef MK_N_LAUNCHES
#define MK_N_LAUNCHES 1
#endif
constexpr int N_LAUNCHES = MK_N_LAUNCHES;

constexpr int BATCH = 4, SEQ = 8192, D = 1024, M = BATCH * SEQ, QW = 3072, NE = 16, FF = 256, HD = 128;
constexpr int HALF_ROWS = M / 2;
constexpr float LN_EPS = 1e-5f, ALPHA = 1.4142135623730951f;
constexpr float LOG2E = 1.4426950408889634f, LN2 = 0.6931471805599453f;
constexpr int ADA_STRIDE = 14336;

constexpr size_t MiB = 1u << 20;
constexpr size_t WS_CTL = 0, CTL_ZERO_BYTES = 1 * MiB;
constexpr size_t WS_TAB = 1 * MiB;
constexpr size_t TAB_ADA = 0, TAB_BT = 256 * 1024, TAB_TE = 320 * 1024, TAB_NT = 328 * 1024;
constexpr size_t WS_WIN = 2 * MiB, WS_WOUT = 8 * MiB, WS_WKV = 10 * MiB, WS_WQ = 22 * MiB, WS_WO = 28 * MiB, WS_WGU = 30 * MiB, WS_WD = 62 * MiB;
constexpr size_t WS_H = 78 * MiB;
constexpr size_t WS_U = 142 * MiB, WS_BG = 206 * MiB;
constexpr size_t WS_HKV = 142 * MiB;
constexpr size_t WS_K = 206 * MiB, WS_V = 302 * MiB, WS_Q = 398 * MiB, WS_LSE = 494 * MiB;
constexpr size_t WS_RT = 504 * MiB, WS_LIST = 505 * MiB, WS_SLOTP = 510 * MiB, WS_SLOTW = 511 * MiB;
constexpr size_t WS_END = 512 * MiB;
constexpr size_t WS_HS0 = 142 * MiB, WS_HE0 = 278 * MiB, WS_Y20 = 312 * MiB, MOE_LSTEP = 64 * MiB;
constexpr int MAXTILES = 272;
constexpr int CW_TMO = 0, CW_BAR = 4096, CW_CNT = 16384;

constexpr int RING_OFF = 0, RING_BYTES = 131072;
constexpr int LDSCTL_OFF = RING_BYTES, MISC_OFF = LDSCTL_OFF + 320;
constexpr int LDS_BYTES = 147456;

__device__ const unsigned char T5_BUCKET[3][129] = {
{0,1,2,3,4,5,6,7,8,9,10,11,12,13,14,15,16,16,16,16,16,16,17,17,17,17,17,17,17,17,18,18,18,18,18,18,18,18,18,18,19,19,19,19,19,19,19,19,19,19,19,19,19,19,20,20,20,20,20,20,20,20,20,20,20,20,20,20,20,20,20,20,20,21,21,21,21,21,21,21,21,21,21,21,21,21,21,21,21,21,21,21,21,21,21,21,21,21,21,22,22,22,22,22,22,22,22,22,22,22,22,22,22,22,22,22,22,22,22,22,22,22,22,22,22,22,22,22,22},
{0,4,8,12,16,16,17,17,18,18,19,19,19,19,20,20,20,20,20,21,21,21,21,21,21,22,22,22,22,22,22,22,22,22,23,23,23,23,23,23,23,23,23,23,23,23,24,24,24,24,24,24,24,24,24,24,24,24,24,24,24,24,25,25,25,25,25,25,25,25,25,25,25,25,25,25,25,25,25,25,25,25,25,26,26,26,26,26,26,26,26,26,26,26,26,26,26,26,26,26,26,26,26,26,26,26,26,26,26,26,26,26,26,27,27,27,27,27,27,27,27,27,27,27,27,27,27,27,27},
{0,16,18,19,20,21,21,22,22,23,23,23,24,24,24,24,25,25,25,25,25,26,26,26,26,26,26,26,26,27,27,27,27,27,27,27,27,27,27,28,28,28,28,28,28,28,28,28,28,28,28,28,29,29,29,29,29,29,29,29,29,29,29,29,29,29,29,29,29,29,30,30,30,30,30,30,30,30,30,30,30,30,30,30,30,30,30,30,30,30,30,30,30,30,30,31,31,31,31,31,31,31,31,31,31,31,31,31,31,31,31,31,31,31,31,31,31,31,31,31,31,31,31,31,31,31,31,31,31}};

struct Frame {
    LAS unsigned char* lds;
    volatile LAS unsigned* MISC;
    gu32* ctl;
    unsigned char* ws;
    int tid, lane, wave;
    int vcu, G;
    int gw, NGW;
};
typedef unsigned u32x2v __attribute__((ext_vector_type(2)));
typedef float f32x16 __attribute__((ext_vector_type(16)));
typedef short s16x4 __attribute__((ext_vector_type(4)));
typedef short v4i16_t __attribute__((ext_vector_type(4)));
typedef float f32x2_t __attribute__((ext_vector_type(2))); typedef __bf16 bf16x2_t __attribute__((ext_vector_type(2)));
__device__ __forceinline__ unsigned cvtpk_s(float lo, float hi) { f32x2_t v = {lo, hi}; bf16x2_t b = __builtin_convertvector(v, bf16x2_t); return __builtin_bit_cast(unsigned, b); }
__device__ __forceinline__ float bflo(unsigned w) { return __uint_as_float(w << 16); }
__device__ __forceinline__ float bfhi(unsigned w) { return __uint_as_float(w & 0xffff0000u); }
__device__ __forceinline__ float wave_sum(float v) {
#pragma unroll
    for (int o = 1; o < 64; o <<= 1) v += __shfl_xor(v, o);
    return v;
}

__device__ __forceinline__ void p0_transpose_item(const float* W, int ldw, int k0, int srccol0, bf16* WT, int ldt, int dstrow0, LAS float* scr, int lane) {
#pragma unroll 8
    for (int i = 0; i < 32; ++i) { const int kk = 2 * i + (lane >> 5); scr[kk * 33 + (lane & 31)] = W[(size_t)(k0 + kk) * ldw + srccol0 + (lane & 31)]; }
    LDS_WAIT(); asm volatile("" ::: "memory");
    const int c = lane & 7;
#pragma unroll
    for (int j = 0; j < 4; ++j) { const int n = (lane >> 3) + 8 * j; const LAS float* s = scr + (8 * c) * 33 + n;
        v4u o; o.x = pk2(s[0 * 33], s[1 * 33]); o.y = pk2(s[2 * 33], s[3 * 33]); o.z = pk2(s[4 * 33], s[5 * 33]); o.w = pk2(s[6 * 33], s[7 * 33]);
        *(GAS v4u*)(WT + (size_t)(dstrow0 + n) * ldt + k0 + 8 * c) = o; }
    LDS_WAIT(); asm volatile("" ::: "memory");
}
struct P0In { const float *c, *ada_w, *ada_b, *conv_w_in, *conv_w_out, *kv_ada_w, *kv_ada_b, *w_kv, *w_q, *w_o, *rel_bias, *wg, *wu, *wd; };
__device__ __forceinline__ void p0_prologue(Frame& F, const P0In& I) {
    {
        LAS float* cond = (LAS float*)(F.lds + RING_OFF);
        LAS float* part = (LAS float*)(F.lds + RING_OFF + 16384);
        for (int i = F.tid; i < BATCH * D; i += NWAVES * 64) { const float v = I.c[i]; cond[i] = v / (1.0f + __expf(-v)); }
        __syncthreads();
        for (int u = F.vcu; u < ADA_STRIDE / 64; u += F.G) {
            const int col = u * 64 + F.lane;
            const float* W; int ld, cc; const float* bias;
            if (col < 6144) { W = I.ada_w; ld = 6144; cc = col; bias = I.ada_b; }
            else if (col < 12288) { W = I.ada_w + (size_t)D * 6144; ld = 6144; cc = col - 6144; bias = I.ada_b + 6144; }
            else { W = I.kv_ada_w; ld = 2048; cc = col - 12288; bias = I.kv_ada_b; }
            float a0 = 0.f, a1 = 0.f, a2 = 0.f, a3 = 0.f;
            const int kb = F.wave * 128;
#pragma unroll 8
            for (int k = 0; k < 128; ++k) { const float w = W[(size_t)(kb + k) * ld + cc];
                a0 += cond[kb + k] * w; a1 += cond[1024 + kb + k] * w; a2 += cond[2048 + kb + k] * w; a3 += cond[3072 + kb + k] * w; }
            part[(F.wave * 4 + 0) * 64 + F.lane] = a0; part[(F.wave * 4 + 1) * 64 + F.lane] = a1; part[(F.wave * 4 + 2) * 64 + F.lane] = a2; part[(F.wave * 4 + 3) * 64 + F.lane] = a3;
            __syncthreads();
            if (F.wave < 4) { float s = bias[cc];
#pragma unroll
                for (int w = 0; w < 8; ++w) s += part[(w * 4 + F.wave) * 64 + F.lane];
                ((float*)(F.ws + WS_TAB + TAB_ADA))[(size_t)F.wave * ADA_STRIDE + col] = s; }
            __syncthreads();
        }
        for (int i = F.vcu * (NWAVES * 64) + F.tid; i < 3 * 8 * 129; i += F.G * NWAVES * 64) {
            const int g = i / (8 * 129), h = (i / 129) % 8, d = i % 129;
            ((float*)(F.ws + WS_TAB + TAB_BT))[i] = I.rel_bias[(int)T5_BUCKET[g][d] * 24 + g * 8 + h] * LOG2E;
        }
        __syncthreads();
    }
    LAS float* scr = (LAS float*)(F.lds + RING_OFF + F.wave * 16384);
    bf16* const Win = (bf16*)(F.ws + WS_WIN); bf16* const Wout = (bf16*)(F.ws + WS_WOUT); bf16* const Wkv = (bf16*)(F.ws + WS_WKV);
    bf16* const Wq = (bf16*)(F.ws + WS_WQ); bf16* const Wo = (bf16*)(F.ws + WS_WO); bf16* const Wgu = (bf16*)(F.ws + WS_WGU); bf16* const Wd = (bf16*)(F.ws + WS_WD);
    constexpr int I_IN = 16 * 96, I_OUT = 16 * 32, I_KV = 16 * 192, I_Q = 16 * 96, I_O = 16 * 32, I_GU = 32 * 256, I_D = 32 * 128;
    constexpr int NITEMS = I_IN + I_OUT + I_KV + I_Q + I_O + I_GU + I_D;
    for (int it = F.gw; it < NITEMS; it += F.NGW) {
        int r = it;
        if (r < I_IN) { const int kb = r / 96, nb = r % 96, n0 = 32 * nb; int src;
            if (n0 < 2048) { const int t = n0 >> 8, j = n0 & 255; src = (j < 128) ? (1024 + 128 * t + j) : (2048 + 128 * t + (j - 128)); } else src = n0 - 2048;
            p0_transpose_item(I.conv_w_in, 3072, 64 * kb, src, Win, 1024, n0, scr, F.lane); continue; } r -= I_IN;
        if (r < I_OUT) { const int kb = r / 32, nb = r % 32; p0_transpose_item(I.conv_w_out, 1024, 64 * kb, 32 * nb, Wout, 1024, 32 * nb, scr, F.lane); continue; } r -= I_OUT;
        if (r < I_KV) { const int kb = r / 192, nb = r % 192; p0_transpose_item(I.w_kv, 6144, 64 * kb, 32 * nb, Wkv, 1024, 32 * nb, scr, F.lane); continue; } r -= I_KV;
        if (r < I_Q) { const int kb = r / 96, nb = r % 96; p0_transpose_item(I.w_q, 3072, 64 * kb, 32 * nb, Wq, 1024, 32 * nb, scr, F.lane); continue; } r -= I_Q;
        if (r < I_O) { const int kb = r / 32, nb = r % 32; p0_transpose_item(I.w_o, 1024, 64 * kb, 32 * nb, Wo, 1024, 32 * nb, scr, F.lane); continue; } r -= I_O;
        if (r < I_GU) { const int le = r / 256, q = r % 256, kb = q / 16, nb = q % 16, n0 = 32 * nb, t = n0 >> 8, j = n0 & 255;
            const float* src = (j < 128) ? (I.wg + (size_t)le * 1024 * 256) : (I.wu + (size_t)le * 1024 * 256); const int sc = 128 * t + (j & 127);
            p0_transpose_item(src, 256, 64 * kb, sc, Wgu + (size_t)le * 512 * 1024, 1024, n0, scr, F.lane); continue; } r -= I_GU;
        { const int le = r / 128, q = r % 128, kb = q / 32, nb = q % 32;
            p0_transpose_item(I.wd + (size_t)le * 256 * 1024, 1024, 64 * kb, 32 * nb, Wd + (size_t)le * 1024 * 256, 256, 32 * nb, scr, F.lane); }
    }
}

__device__ __forceinline__ void store_mod_bf16(bf16* orow, const f32x4 (&v)[4], const float* shift, const float* scale, int lane) {
    GAS unsigned long long* o8 = (GAS unsigned long long*)orow + lane;
#pragma unroll
    for (int j = 0; j < 4; ++j) { const f32x4 sh = ((const f32x4*)shift)[lane + 64 * j], sc = ((const f32x4*)scale)[lane + 64 * j]; const f32x4 h = v[j] * (sc + 1.0f) + sh;
        o8[64 * j] = (unsigned long long)cvtpk_s(h[0], h[1]) | ((unsigned long long)cvtpk_s(h[2], h[3]) << 32); }
}
__device__ __forceinline__ void p1_mod0(Frame& F, const float* x) {
    const float* ada = (const float*)(F.ws + WS_TAB + TAB_ADA); bf16* H = (bf16*)(F.ws + WS_H);
    for (int row = F.gw; row < M; row += F.NGW) { const int b = row >> 13;
        f32x4 v[4];
#pragma unroll
        for (int j = 0; j < 4; ++j) v[j] = ((const f32x4*)(x + (size_t)row * D))[F.lane + 64 * j];
        store_mod_bf16(H + (size_t)row * D, v, ada + (size_t)b * ADA_STRIDE + 0, ada + (size_t)b * ADA_STRIDE + 1024, F.lane); }
}
__device__ __forceinline__ void p3_conv(Frame& F, const float* conv_w) {
    const bf16* U = (const bf16*)(F.ws + WS_U); const bf16* BG = (const bf16*)(F.ws + WS_BG); bf16* Z = (bf16*)(F.ws + WS_H);
    float w0[16], w1[16], w2[16];
#pragma unroll
    for (int j = 0; j < 2; ++j)
#pragma unroll
        for (int k = 0; k < 8; ++k) { const int col = 512 * j + 8 * F.lane + k; w0[8 * j + k] = conv_w[col]; w1[8 * j + k] = conv_w[1024 + col]; w2[8 * j + k] = conv_w[2048 + col]; }
    for (int run = F.gw; run < M / 16; run += F.NGW) {
        const int r0 = run * 16; const int t0 = r0 & (SEQ - 1);
        float um1[16], um2[16];
        if (t0 == 0) {
#pragma unroll
            for (int k = 0; k < 16; ++k) { um1[k] = 0.f; um2[k] = 0.f; }
        } else {
#pragma unroll
            for (int j = 0; j < 2; ++j) { const v4u a = *(const v4u*)(U + (size_t)(r0 - 1) * D + 512 * j + 8 * F.lane), b = *(const v4u*)(U + (size_t)(r0 - 2) * D + 512 * j + 8 * F.lane);
#pragma unroll
                for (int k = 0; k < 4; ++k) { um1[8 * j + 2 * k] = bflo(a[k]); um1[8 * j + 2 * k + 1] = bfhi(a[k]); um2[8 * j + 2 * k] = bflo(b[k]); um2[8 * j + 2 * k + 1] = bfhi(b[k]); } }
        }
#pragma unroll 4
        for (int i = 0; i < 16; ++i) { const size_t ro = (size_t)(r0 + i) * D;
#pragma unroll
            for (int j = 0; j < 2; ++j) { const v4u uu = *(const v4u*)(U + ro + 512 * j + 8 * F.lane), bb = *(const v4u*)(BG + ro + 512 * j + 8 * F.lane); v4u o;
#pragma unroll
                for (int k = 0; k < 4; ++k) { const int e0 = 8 * j + 2 * k, e1 = e0 + 1; const float u0 = bflo(uu[k]), u1 = bfhi(uu[k]);
                    const float z0 = bflo(bb[k]) * (w0[e0] * um2[e0] + w1[e0] * um1[e0] + w2[e0] * u0), z1 = bfhi(bb[k]) * (w0[e1] * um2[e1] + w1[e1] * um1[e1] + w2[e1] * u1);
                    um2[e0] = um1[e0]; um1[e0] = u0; um2[e1] = um1[e1]; um1[e1] = u1; o[k] = cvtpk_s(z0, z1); }
                *(v4u*)(Z + ro + 512 * j + 8 * F.lane) = o; } }
    }
}

struct RouteT { int e0, e1; float w0, w1; };
__device__ __forceinline__ void lnr_phase(Frame& F, int layer, float* X, bf16* H2, const float* ln_g, const float* ln_b, const float* router_w, const float* router_bias) {
    LAS float* RWt = (LAS float*)(F.lds + RING_OFF);
    LAS int* lcnt = (LAS int*)(F.lds + RING_OFF + 65536);
    LAS int* gbase = (LAS int*)(F.lds + RING_OFF + 65536 + 64);
    LAS int* ent = (LAS int*)(F.lds + RING_OFF + 65536 + 128);
    const float* ada = (const float*)(F.ws + WS_TAB + TAB_ADA) + layer * 6144;
    RouteT* RT = (RouteT*)(F.ws + WS_RT); int* LIST = (int*)(F.ws + WS_LIST);
    for (int idx = F.tid; idx < 16384; idx += NWAVES * 64) RWt[(idx & 15) * 1024 + (idx >> 4)] = router_w[idx];
    float rb[16];
#pragma unroll
    for (int e = 0; e < 16; ++e) rb[e] = router_bias[e];
    const float* gg = ln_g + (size_t)(layer * 2 + 0) * D; const float* gb = ln_b + (size_t)(layer * 2 + 0) * D;
    for (int rbk = F.vcu; rbk < M / 128; rbk += F.G) {
        if (F.tid < 16) lcnt[F.tid] = 0;
        __syncthreads();
        for (int it = 0; it < 16; ++it) {
            const int row = rbk * 128 + F.wave * 16 + it, b = row >> 13;
            f32x4 v[4]; float s = 0.f;
#pragma unroll
            for (int j = 0; j < 4; ++j) { v[j] = ((const f32x4*)(X + (size_t)row * D))[F.lane + 64 * j]; s += (v[j][0] + v[j][1]) + (v[j][2] + v[j][3]); }
            const float mean = wave_sum(s) * (1.f / D); float s2 = 0.f;
#pragma unroll
            for (int j = 0; j < 4; ++j) { v[j] = v[j] - mean; s2 += (v[j][0] * v[j][0] + v[j][1] * v[j][1]) + (v[j][2] * v[j][2] + v[j][3] * v[j][3]); }
            const float rstd = 1.f / sqrtf(wave_sum(s2) * (1.f / D) + LN_EPS);
            f32x4 hv[4];
            const float* shp = ada + (size_t)b * ADA_STRIDE + 3072; const float* scp = ada + (size_t)b * ADA_STRIDE + 4096;
            GAS unsigned long long* o8 = (GAS unsigned long long*)(H2 + (size_t)row * D) + F.lane;
#pragma unroll
            for (int j = 0; j < 4; ++j) { const f32x4 g4 = ((const f32x4*)gg)[F.lane + 64 * j], b4 = ((const f32x4*)gb)[F.lane + 64 * j];
                v[j] = v[j] * rstd * g4 + b4; ((f32x4*)(X + (size_t)row * D))[F.lane + 64 * j] = v[j];
                const f32x4 sh = ((const f32x4*)shp)[F.lane + 64 * j], sc = ((const f32x4*)scp)[F.lane + 64 * j]; hv[j] = v[j] * (sc + 1.0f) + sh;
                o8[64 * j] = (unsigned long long)cvtpk_s(hv[j][0], hv[j][1]) | ((unsigned long long)cvtpk_s(hv[j][2], hv[j][3]) << 32); }
            float lg[16];
#pragma unroll
            for (int e = 0; e < 16; ++e) { float p = 0.f;
#pragma unroll
                for (int j = 0; j < 4; ++j) { const f32x4 w = *(const LAS f32x4*)(RWt + e * 1024 + 4 * F.lane + 256 * j); p += (hv[j][0] * w[0] + hv[j][1] * w[1]) + (hv[j][2] * w[2] + hv[j][3] * w[3]); }
                lg[e] = wave_sum(p); }
            int e0 = 0, e1 = 1; float a0 = 0.f, a1 = 0.f, best = -INFINITY;
#pragma unroll
            for (int g4 = 0; g4 < 4; ++g4) { float af[4], sl[4];
#pragma unroll
                for (int k = 0; k < 4; ++k) { af[k] = 1.0f / (1.0f + __expf(-lg[4 * g4 + k])); sl[k] = af[k] + rb[4 * g4 + k]; }
                int i0 = 0; float m0 = sl[0];
#pragma unroll
                for (int k = 1; k < 4; ++k) if (sl[k] > m0) { m0 = sl[k]; i0 = k; }
                int i1 = -1; float m1 = -INFINITY;
#pragma unroll
                for (int k = 0; k < 4; ++k) if (k != i0 && sl[k] > m1) { m1 = sl[k]; i1 = k; }
                const float gs = m0 + m1;
                if (gs > best) { best = gs; e0 = 4 * g4 + i0; e1 = 4 * g4 + i1;
                    float x0 = af[0], x1 = af[0];
#pragma unroll
                    for (int k = 1; k < 4; ++k) { x0 = (i0 == k) ? af[k] : x0; x1 = (i1 == k) ? af[k] : x1; }
                    a0 = x0; a1 = x1; } }
            if (F.lane == 0) { const float inv = 1.0f / (a0 + a1);
                RouteT r; r.e0 = e0; r.e1 = e1; r.w0 = a0 * inv; r.w1 = a1 * inv; RT[row] = r;
                const int p0 = atomicAdd((int*)&lcnt[e0], 1), p1 = atomicAdd((int*)&lcnt[e1], 1);
                ent[(F.wave * 16 + it) * 2 + 0] = (e0 << 16) | p0; ent[(F.wave * 16 + it) * 2 + 1] = (e1 << 16) | p1; }
        }
        __syncthreads();
        if (F.tid < 16) gbase[F.tid] = (int)__hip_atomic_fetch_add(F.ctl + CW_CNT + (layer * 16 + F.tid) * 64, (unsigned)lcnt[F.tid], RLX_AGENT);
        __syncthreads();
        if (F.tid < 256) { const int en = ent[F.tid], e = en >> 16, lp = en & 0xffff; LIST[(size_t)e * 65536 + gbase[e] + lp] = (rbk * 128 + (F.tid >> 1)) * 2 + (F.tid & 1); }
        __syncthreads();
    }
}
__device__ __forceinline__ void moeprep_phase(Frame& F, int layer, const bf16* H2, bf16* HS) {
    int cn[16], tb[17]; tb[0] = 0;
#pragma unroll
    for (int e = 0; e < 16; ++e) { cn[e] = (int)__builtin_amdgcn_readfirstlane(__hip_atomic_load(F.ctl + CW_CNT + (layer * 16 + e) * 64, RLX_AGENT)); tb[e + 1] = tb[e] + ((cn[e] + 255) >> 8); }
    const int NT = tb[16];
    int* TE = (int*)(F.ws + WS_TAB + TAB_TE) + layer * 512; int* NTW = (int*)(F.ws + WS_TAB + TAB_NT);
    const RouteT* RT = (const RouteT*)(F.ws + WS_RT); const int* LIST = (const int*)(F.ws + WS_LIST);
    int* SLOTP = (int*)(F.ws + WS_SLOTP); float* SLOTW = (float*)(F.ws + WS_SLOTW);
    if (F.vcu == 0) {
        for (int T = F.tid; T < NT; T += NWAVES * 64) { int e = 0;
#pragma unroll
            for (int k = 1; k < 16; ++k) if (T >= tb[k]) e = k;
            TE[T] = e; }
        if (F.tid == 0) NTW[layer] = NT;
    }
    for (int s = F.gw; s < NT * 256; s += F.NGW) {
        const int T = s >> 8; int e = 0, tbe = 0, ce = cn[0];
#pragma unroll
        for (int k = 1; k < 16; ++k) if (T >= tb[k]) { e = k; tbe = tb[k]; ce = cn[k]; }
        const int pos = s - tbe * 256; const bool valid = pos < ce;
        int pair = -1; float w = 0.f; v4u a = (v4u){0u, 0u, 0u, 0u}, b = a;
        if (valid) { pair = LIST[(size_t)e * 65536 + pos]; const int row = pair >> 1; const RouteT r = RT[row]; w = (pair & 1) ? r.w1 : r.w0;
            a = *(const v4u*)(H2 + (size_t)row * D + 8 * F.lane); b = *(const v4u*)(H2 + (size_t)row * D + 512 + 8 * F.lane); }
        *(v4u*)(HS + (size_t)s * D + 8 * F.lane) = a; *(v4u*)(HS + (size_t)s * D + 512 + 8 * F.lane) = b;
        if (F.lane == 0) { SLOTP[s] = pair; SLOTW[s] = w; }
    }
}
__device__ __forceinline__ void ln2_phase(Frame& F, int layer, float* X, const bf16* Y2, const float* ln_g, const float* ln_b, bool write_next) {
    const float* adab = (const float*)(F.ws + WS_TAB + TAB_ADA);
    const float* gg = ln_g + (size_t)(layer * 2 + 1) * D; const float* gb = ln_b + (size_t)(layer * 2 + 1) * D;
    bf16* HQ = (bf16*)(F.ws + WS_H); bf16* HKV = (bf16*)(F.ws + WS_HKV);
    for (int row = F.gw; row < M; row += F.NGW) { const int b = row >> 13;
        const float* g2 = adab + (size_t)b * ADA_STRIDE + layer * 6144 + 5120;
        f32x4 v[4]; float s = 0.f;
#pragma unroll
        for (int j = 0; j < 4; ++j) { const f32x4 xv = ((const f32x4*)(X + (size_t)row * D))[F.lane + 64 * j]; const f32x4 gv = ((const f32x4*)g2)[F.lane + 64 * j] + 1.0f;
            const u32x2v ya = ((const u32x2v*)(Y2 + (size_t)(2 * row) * D))[F.lane + 64 * j], yb = ((const u32x2v*)(Y2 + (size_t)(2 * row + 1) * D))[F.lane + 64 * j];
            f32x4 y; y[0] = bflo(ya[0]) + bflo(yb[0]); y[1] = bfhi(ya[0]) + bfhi(yb[0]); y[2] = bflo(ya[1]) + bflo(yb[1]); y[3] = bfhi(ya[1]) + bfhi(yb[1]);
            v[j] = xv * ALPHA + gv * y; s += (v[j][0] + v[j][1]) + (v[j][2] + v[j][3]); }
        const float mean = wave_sum(s) * (1.f / D); float s2 = 0.f;
#pragma unroll
        for (int j = 0; j < 4; ++j) { v[j] = v[j] - mean; s2 += (v[j][0] * v[j][0] + v[j][1] * v[j][1]) + (v[j][2] * v[j][2] + v[j][3] * v[j][3]); }
        const float rstd = 1.f / sqrtf(wave_sum(s2) * (1.f / D) + LN_EPS);
#pragma unroll
        for (int j = 0; j < 4; ++j) { const f32x4 g4 = ((const f32x4*)gg)[F.lane + 64 * j], b4 = ((const f32x4*)gb)[F.lane + 64 * j];
            v[j] = v[j] * rstd * g4 + b4; ((f32x4*)(X + (size_t)row * D))[F.lane + 64 * j] = v[j]; }
        if (write_next) {
            store_mod_bf16(HQ + (size_t)row * D, v, adab + (size_t)b * ADA_STRIDE + 6144 + 0, adab + (size_t)b * ADA_STRIDE + 6144 + 1024, F.lane);
            store_mod_bf16(HKV + (size_t)row * D, v, adab + (size_t)b * ADA_STRIDE + 12288 + 0, adab + (size_t)b * ADA_STRIDE + 12288 + 1024, F.lane);
        }
    }
}

__device__ __forceinline__ int crow(int r, int hi) { return (r & 3) + 8 * (r >> 2) + 4 * hi; }
__device__ __forceinline__ unsigned off_b(unsigned row, unsigned ch) { return 256u * row + 16u * (ch ^ (((row & 3) << 2) | ((row >> 2) & 3))); }
typedef __attribute__((address_space(3))) const char* lds_cptr;
__device__ __forceinline__ s16x4 vtr(lds_cptr p) { return __builtin_bit_cast(s16x4, __builtin_amdgcn_ds_read_tr16_b64_v4i16((__attribute__((address_space(3))) v4i16_t*)p)); }
__device__ __forceinline__ void attn_tile(bf16* Qh, const bf16* Kh, const bf16* Vh, float* LSEh, const float* BT, int g, int bl, int h, int r, int i, LAS unsigned char* vl, int lane) {
    const int sh = 2 * g, ql = lane & 31, hh = lane >> 5, colb = g * 1024 + h * HD;
    const size_t row0 = (size_t)bl * SEQ + r;
    const size_t qrow = row0 + ((size_t)(32 * i + ql) << sh);
    bf16x8 qf[8];
#pragma unroll
    for (int s = 0; s < 8; ++s) qf[s] = *(const bf16x8*)(Qh + qrow * QW + colb + 8 * hh + 16 * s);
    f32x16 o[4];
#pragma unroll
    for (int c = 0; c < 4; ++c)
#pragma unroll
        for (int k = 0; k < 16; ++k) o[c][k] = 0.f;
    float m = -1e30f, l = 0.f;
    const float* bt = BT + (g * 8 + h) * 129;
    const float scl = 0.08838834764831845f * LOG2E;
    const int tq = (lane & 15) >> 2, tp = lane & 3, tblk = (lane >> 4) & 1;
    for (int kt = 4; kt >= 0; --kt) {
        const int kp0 = 32 * i - 128 + 32 * kt;
        if (kp0 + 31 < 0) break;
        int kp = kp0 + ql; kp = kp < 0 ? 0 : kp;
        const bf16* kptr = Kh + (row0 + ((size_t)kp << sh)) * QW + colb + 8 * hh;
        bf16x8 kf[8];
#pragma unroll
        for (int s = 0; s < 8; ++s) kf[s] = *(const bf16x8*)(kptr + 16 * s);
        v4u vv[8];
#pragma unroll
        for (int ii = 0; ii < 8; ++ii) { const int n = lane + 64 * ii, vr = n >> 4, ch = n & 15; int kr = kp0 + vr; kr = kr < 0 ? 0 : kr;
            vv[ii] = *(const v4u*)(Vh + (row0 + ((size_t)kr << sh)) * QW + colb + ch * 8); }
        f32x16 sc;
#pragma unroll
        for (int k = 0; k < 16; ++k) sc[k] = 0.f;
#pragma unroll
        for (int s = 0; s < 8; ++s) sc = __builtin_amdgcn_mfma_f32_32x32x16_bf16(kf[s], qf[s], sc, 0, 0, 0);
#pragma unroll
        for (int ii = 0; ii < 8; ++ii) { const int n = lane + 64 * ii, vr = n >> 4, ch = n & 15; *(LAS v4u*)(vl + off_b(vr, ch)) = vv[ii]; }
        float mx = -INFINITY;
#pragma unroll
        for (int k = 0; k < 16; ++k) { const int kloc = crow(k, hh); const int dist = 128 + ql - 32 * kt - kloc; const bool valid = (dist >= 0) && (dist <= 128) && (kp0 + kloc >= 0);
            const int dc = dist < 0 ? 0 : (dist > 128 ? 128 : dist);
            const float v = valid ? sc[k] * scl + bt[dc] : -INFINITY; sc[k] = v; mx = fmaxf(mx, v); }
        mx = fmaxf(mx, __shfl_xor(mx, 32));
        const float mn = fmaxf(m, mx), alpha = __builtin_amdgcn_exp2f(m - mn); m = mn;
        float ls = 0.f;
#pragma unroll
        for (int k = 0; k < 16; ++k) { const float p = __builtin_amdgcn_exp2f(sc[k] - mn); sc[k] = p; ls += p; }
        ls += __shfl_xor(ls, 32); l = l * alpha + ls;
#pragma unroll
        for (int c = 0; c < 4; ++c)
#pragma unroll
            for (int k = 0; k < 16; ++k) o[c][k] *= alpha;
        bf16x8 pf[2];
#pragma unroll
        for (int s = 0; s < 2; ++s) { v4u w; w.x = cvtpk_s(sc[8 * s + 0], sc[8 * s + 1]); w.y = cvtpk_s(sc[8 * s + 2], sc[8 * s + 3]); w.z = cvtpk_s(sc[8 * s + 4], sc[8 * s + 5]); w.w = cvtpk_s(sc[8 * s + 6], sc[8 * s + 7]); pf[s] = __builtin_bit_cast(bf16x8, w); }
#pragma unroll
        for (int c = 0; c < 4; ++c)
#pragma unroll
            for (int s = 0; s < 2; ++s) {
                const s16x4 lo = vtr((lds_cptr)(vl + off_b(16 * s + 0 + 4 * hh + tq, 4 * c + 2 * tblk + (tp >> 1)) + 8 * (tp & 1)));
                const s16x4 hi = vtr((lds_cptr)(vl + off_b(16 * s + 8 + 4 * hh + tq, 4 * c + 2 * tblk + (tp >> 1)) + 8 * (tp & 1)));
                const bf16x8 va = (bf16x8){lo[0], lo[1], lo[2], lo[3], hi[0], hi[1], hi[2], hi[3]};
                o[c] = __builtin_amdgcn_mfma_f32_32x32x16_bf16(va, pf[s], o[c], 0, 0, 0);
            }
    }
    const float inv = 1.0f / l;
    bf16* op = Qh + qrow * QW + colb;
#pragma unroll
    for (int c = 0; c < 4; ++c)
#pragma unroll
        for (int gq = 0; gq < 4; ++gq) { u32x2v w; w.x = cvtpk_s(o[c][4 * gq + 0] * inv, o[c][4 * gq + 1] * inv); w.y = cvtpk_s(o[c][4 * gq + 2] * inv, o[c][4 * gq + 3] * inv);
            *(u32x2v*)(op + 32 * c + 8 * gq + 4 * hh) = w; }
    if (hh == 0) LSEh[qrow * 24 + g * 8 + h] = (m + __builtin_amdgcn_logf(l)) * LN2;
}
__device__ __forceinline__ void attn_phase(Frame& F) {
    bf16* Qh = (bf16*)(F.ws + WS_Q); const bf16* Kh = (const bf16*)(F.ws + WS_K); const bf16* Vh = (const bf16*)(F.ws + WS_V);
    float* LSEh = (float*)(F.ws + WS_LSE); const float* BT = (const float*)(F.ws + WS_TAB + TAB_BT);
    LAS unsigned char* vl = F.lds + RING_OFF + F.wave * 8192;
    constexpr int PER_G = 2 * 8 * (SEQ / 32);
    for (int t = F.gw; t < 3 * PER_G; t += F.NGW) {
        const int g = t / PER_G, q = t % PER_G, sh = 2 * g;
        const int nsub = (SEQ / 32) >> sh;
        const int i = q % nsub, r = (q / nsub) & ((1 << sh) - 1), hq = q / (SEQ / 32), h = hq & 7, bl = hq >> 3;
        attn_tile(Qh, Kh, Vh, LSEh, BT, g, bl, h, r, i, vl, F.lane);
    }
}
__device__ __forceinline__ void mix_phase(Frame& F, int half) {
    const bf16* Oh = (const bf16*)(F.ws + WS_Q); const float* LSEh = (const float*)(F.ws + WS_LSE); bf16* MIX = (bf16*)(F.ws + WS_H);
    for (int lr = F.gw; lr < HALF_ROWS; lr += F.NGW) {
#pragma unroll
        for (int j = 0; j < 2; ++j) { const int col = 512 * j + 8 * F.lane, h = col >> 7;
            const float l0 = LSEh[(size_t)lr * 24 + h], l1 = LSEh[(size_t)lr * 24 + 8 + h], l2 = LSEh[(size_t)lr * 24 + 16 + h];
            const float mx = fmaxf(l0, fmaxf(l1, l2)); float e0 = __expf(l0 - mx), e1 = __expf(l1 - mx), e2 = __expf(l2 - mx); const float inv = 1.0f / (e0 + e1 + e2); e0 *= inv; e1 *= inv; e2 *= inv;
            const v4u a = *(const v4u*)(Oh + (size_t)lr * QW + col), b = *(const v4u*)(Oh + (size_t)lr * QW + 1024 + col), c = *(const v4u*)(Oh + (size_t)lr * QW + 2048 + col); v4u o;
#pragma unroll
            for (int k = 0; k < 4; ++k) o[k] = cvtpk_s(e0 * bflo(a[k]) + e1 * bflo(b[k]) + e2 * bflo(c[k]), e0 * bfhi(a[k]) + e1 * bfhi(b[k]) + e2 * bfhi(c[k]));
            *(v4u*)(MIX + (size_t)(half * HALF_ROWS + lr) * D + col) = o; }
    }
}

struct Args { const float* in[20]; float* out; unsigned char* ws; int ph_lo, ph_hi, li, pad; };
__global__ void __launch_bounds__(NWAVES * 64, 2) yoco_fwd(Args args) {
    extern __shared__ __attribute__((aligned(16))) unsigned char lds[];
    Frame F;
    F.lds = (LAS unsigned char*)lds;
    F.MISC = (volatile LAS unsigned*)(F.lds + MISC_OFF);
    F.tid = threadIdx.x; F.lane = F.tid & 63; F.wave = __builtin_amdgcn_readfirstlane(F.tid >> 6);
    F.G = gridDim.x; { const int bx = blockIdx.x; F.vcu = (F.G % 8 == 0) ? (bx % 8) * (F.G / 8) + bx / 8 : bx; }
    F.gw = F.vcu * NWAVES + F.wave; F.NGW = F.G * NWAVES;
    F.ws = args.ws; F.ctl = (gu32*)(args.ws + WS_CTL);
    for (int u = F.tid; u < (LDS_BYTES - LDSCTL_OFF) / 4; u += NWAVES * 64) ((LAS unsigned*)(F.lds + LDSCTL_OFF))[u] = 0u;
    __syncthreads();
    XcdBarrier bar; bar.bar = (unsigned*)(F.ctl + CW_BAR); bar.x = 0; bar.st = nullptr;
    if (N_LAUNCHES == 1) bar = xcd_barrier_post((unsigned*)(F.ctl + CW_BAR), F.MISC + 8);
#define GRID_BAR() do { if (N_LAUNCHES == 1) { xcd_barrier(bar); } } while (0)
    const int lo = args.ph_lo, hi = args.ph_hi;
#ifndef PH_MASK
#define PH_MASK 0xffffffffu
#endif
#define IN(k) ((((PH_MASK) >> (k)) & 1u) && lo <= (k) && (k) < hi)
#define BOTH(k) (IN(k) && IN((k) + 1))
    const float* x = args.in[0]; const float* ln_g = args.in[4]; const float* ln_b = args.in[5];
    float* X = args.out;
    unsigned char* ws = args.ws;
    const float* ADA = (const float*)(ws + WS_TAB + TAB_ADA);

    if (IN(0)) { P0In I{args.in[1], args.in[2], args.in[3], args.in[6], args.in[8], args.in[9], args.in[10], args.in[11], args.in[12], args.in[13], args.in[14], args.in[17], args.in[18], args.in[19]};
        p0_prologue(F, I); if (BOTH(0)) GRID_BAR(); }
    if (IN(1)) { p1_mod0(F, x); if (BOTH(1)) GRID_BAR(); }
    if (IN(2)) {
        pg8::Gemm g{(const bf16*)(ws + WS_H), (const bf16*)(ws + WS_WIN), M, 3072, D}; pg8::StaticOrder S; S.init(M, 3072, F.G, (int)blockIdx.x);
        pg8::EpiCV E{(bf16*)(ws + WS_U), (bf16*)(ws + WS_BG)};
        pg8::gemm_phase<pg8::EpiCV, pg8::StaticOrder, true, true>(F.lds + RING_OFF, g, S, E);
        if (BOTH(2)) GRID_BAR(); }
    if (IN(3)) { p3_conv(F, args.in[7]); if (BOTH(3)) GRID_BAR(); }
    if (IN(4)) {
        pg8::Gemm g{(const bf16*)(ws + WS_H), (const bf16*)(ws + WS_WOUT), M, D, D}; pg8::StaticOrder S; S.init(M, D, F.G, (int)blockIdx.x);
        pg8::EpiRes E{x, X, ADA + 2048, ADA_STRIDE, SEQ, ALPHA};
        pg8::gemm_phase<pg8::EpiRes, pg8::StaticOrder, true, true>(F.lds + RING_OFF, g, S, E);
        if (BOTH(4)) GRID_BAR(); }
    if (IN(5)) { lnr_phase(F, 0, X, (bf16*)(ws + WS_H), ln_g, ln_b, args.in[15], args.in[16]); if (BOTH(5)) GRID_BAR(); }
    if (IN(6)) { moeprep_phase(F, 0, (const bf16*)(ws + WS_H), (bf16*)(ws + WS_HS0)); if (BOTH(6)) GRID_BAR(); }
    if (IN(7)) {
        const int NT = __builtin_amdgcn_readfirstlane(((const int*)(ws + WS_TAB + TAB_NT))[0]);
        pg8::Gemm g{(const bf16*)(ws + WS_HS0), (const bf16*)(ws + WS_WGU), MAXTILES * 256, 16 * 512, D};
        pg8::MoeSched S{(const int*)(ws + WS_TAB + TAB_TE), NT, 2, F.G, F.vcu};
        pg8::EpiMoeUp E{(bf16*)(ws + WS_HE0)};
        pg8::gemm_phase<pg8::EpiMoeUp, pg8::MoeSched, true, true>(F.lds + RING_OFF, g, S, E);
        if (BOTH(7)) GRID_BAR(); }
    if (IN(8)) {
        const int NT = __builtin_amdgcn_readfirstlane(((const int*)(ws + WS_TAB + TAB_NT))[0]);
        pg8::Gemm g{(const bf16*)(ws + WS_HE0), (const bf16*)(ws + WS_WD), MAXTILES * 256, 16 * 1024, FF};
        pg8::MoeSched S{(const int*)(ws + WS_TAB + TAB_TE), NT, 4, F.G, F.vcu};
        pg8::EpiMoeDown E{(const int*)(ws + WS_SLOTP), (const float*)(ws + WS_SLOTW), (bf16*)(ws + WS_Y20)};
        pg8::gemm_phase<pg8::EpiMoeDown, pg8::MoeSched, true, true>(F.lds + RING_OFF, g, S, E);
        if (BOTH(8)) GRID_BAR(); }
    if (IN(9)) { ln2_phase(F, 0, X, (const bf16*)(ws + WS_Y20), ln_g, ln_b, true); if (BOTH(9)) GRID_BAR(); }
#define KVQ_PHASE(half) do { \
        { pg8::Gemm g{(const bf16*)(ws + WS_HKV) + (size_t)(half) * HALF_ROWS * D, (const bf16*)(ws + WS_WKV), HALF_ROWS, 6144, D}; pg8::StaticOrder S; S.init(HALF_ROWS, 6144, F.G, (int)blockIdx.x); \
          pg8::EpiBf16<0> E{(bf16*)(ws + WS_K), QW, nullptr, QW, (size_t)(WS_V - WS_K) / 2, 1.0f}; \
          pg8::gemm_phase<pg8::EpiBf16<0>, pg8::StaticOrder, true, true>(F.lds + RING_OFF, g, S, E); } \
        __syncthreads(); \
        { pg8::Gemm g{(const bf16*)(ws + WS_H) + (size_t)(half) * HALF_ROWS * D, (const bf16*)(ws + WS_WQ), HALF_ROWS, QW, D}; pg8::StaticOrder S; S.init(HALF_ROWS, QW, F.G, (int)blockIdx.x); \
          pg8::EpiBf16<0> E{(bf16*)(ws + WS_Q), QW, nullptr, 0, 0, 1.0f}; \
          pg8::gemm_phase<pg8::EpiBf16<0>, pg8::StaticOrder, true, true>(F.lds + RING_OFF, g, S, E); } } while (0)
    if (IN(10)) { KVQ_PHASE(0); if (BOTH(10)) GRID_BAR(); }
    if (IN(11)) { attn_phase(F); if (BOTH(11)) GRID_BAR(); }
    if (IN(12)) { mix_phase(F, 0); if (BOTH(12)) GRID_BAR(); }
    if (IN(13)) { KVQ_PHASE(1); if (BOTH(13)) GRID_BAR(); }
    if (IN(14)) { attn_phase(F); if (BOTH(14)) GRID_BAR(); }
    if (IN(15)) { mix_phase(F, 1); if (BOTH(15)) GRID_BAR(); }
    if (IN(16)) {
        pg8::Gemm g{(const bf16*)(ws + WS_H), (const bf16*)(ws + WS_WO), M, D, D}; pg8::StaticOrder S; S.init(M, D, F.G, (int)blockIdx.x);
        pg8::EpiRes E{X, X, ADA + 6144 + 2048, ADA_STRIDE, SEQ, ALPHA};
        pg8::gemm_phase<pg8::EpiRes, pg8::StaticOrder, true, true>(F.lds + RING_OFF, g, S, E);
        if (BOTH(16)) GRID_BAR(); }
    if (IN(17)) { lnr_phase(F, 1, X, (bf16*)(ws + WS_HKV), ln_g, ln_b, args.in[15], args.in[16]); if (BOTH(17)) GRID_BAR(); }
    if (IN(18)) { moeprep_phase(F, 1, (const bf16*)(ws + WS_HKV), (bf16*)(ws + WS_HS0 + MOE_LSTEP)); if (BOTH(18)) GRID_BAR(); }
    if (IN(19)) {
        const int NT = __builtin_amdgcn_readfirstlane(((const int*)(ws + WS_TAB + TAB_NT))[1]);
        pg8::Gemm g{(const bf16*)(ws + WS_HS0 + MOE_LSTEP), (const bf16*)(ws + WS_WGU) + (size_t)16 * 512 * 1024, MAXTILES * 256, 16 * 512, D};
        pg8::MoeSched S{(const int*)(ws + WS_TAB + TAB_TE) + 512, NT, 2, F.G, F.vcu};
        pg8::EpiMoeUp E{(bf16*)(ws + WS_HE0 + MOE_LSTEP)};
        pg8::gemm_phase<pg8::EpiMoeUp, pg8::MoeSched, true, true>(F.lds + RING_OFF, g, S, E);
        if (BOTH(19)) GRID_BAR(); }
    if (IN(20)) {
        const int NT = __builtin_amdgcn_readfirstlane(((const int*)(ws + WS_TAB + TAB_NT))[1]);
        pg8::Gemm g{(const bf16*)(ws + WS_HE0 + MOE_LSTEP), (const bf16*)(ws + WS_WD) + (size_t)16 * 1024 * 256, MAXTILES * 256, 16 * 1024, FF};
        pg8::MoeSched S{(const int*)(ws + WS_TAB + TAB_TE) + 512, NT, 4, F.G, F.vcu};
        pg8::EpiMoeDown E{(const int*)(ws + WS_SLOTP), (const float*)(ws + WS_SLOTW), (bf16*)(ws + WS_Y20 + MOE_LSTEP)};
        pg8::gemm_phase<pg8::EpiMoeDown, pg8::MoeSched, true, true>(F.lds + RING_OFF, g, S, E);
        if (BOTH(20)) GRID_BAR(); }
    if (IN(21)) { ln2_phase(F, 1, X, (const bf16*)(ws + WS_Y20 + MOE_LSTEP), ln_g, ln_b, false); }
#undef IN
#undef BOTH
}

extern "C" void kernel_launch(void* const* d_in, const int* in_sizes, int n_in, void* d_out, int out_size, void* d_ws, size_t ws_size, hipStream_t stream) {
    static int grid = 0;
    if (grid == 0) {
        if (n_in != 20 || in_sizes[0] != M * D || out_size != M * D || ws_size < WS_END) { fprintf(stderr, "kernel_launch: unexpected shapes / workspace (n_in %d, in0 %d, out %d, ws %zu)\n", n_in, n_in > 0 ? in_sizes[0] : -1, out_size, ws_size); grid = -1; return; }
        int dev = 0, cus = 0, per_cu = 0;
        if (hipGetDevice(&dev) != hipSuccess || hipDeviceGetAttribute(&cus, hipDeviceAttributeMultiprocessorCount, dev) != hipSuccess) { grid = -1; return; }
        if (hipFuncSetAttribute((const void*)yoco_fwd, hipFuncAttributeMaxDynamicSharedMemorySize, LDS_BYTES) != hipSuccess) { grid = -1; return; }
        if (hipOccupancyMaxActiveBlocksPerMultiprocessor(&per_cu, (const void*)yoco_fwd, NWAVES * 64, LDS_BYTES) != hipSuccess || per_cu < 1)
            fprintf(stderr, "kernel_launch: occupancy query reports %d workgroups per CU\n", per_cu);
        (void)hipGetLastError();
        grid = cus;
    }
    if (grid < 0) return;
    if (hipMemsetAsync((char*)d_ws + WS_CTL, 0, CTL_ZERO_BYTES, stream) != hipSuccess) return;
    Args a{};
    for (int i = 0; i < 20; ++i) a.in[i] = (const float*)d_in[i];
    a.out = (float*)d_out; a.ws = (unsigned char*)d_ws; a.pad = 0;
    if (N_LAUNCHES == 1) { a.ph_lo = 0; a.ph_hi = NPHASE; a.li = 0;
        hipLaunchKernelGGL(yoco_fwd, dim3(grid), dim3(NWAVES * 64), LDS_BYTES, stream, a);
    } else {
        for (int li = 0; li < NPHASE; ++li) { a.ph_lo = li; a.ph_hi = li + 1; a.li = li;
            hipLaunchKernelGGL(yoco_fwd, dim3(grid), dim3(NWAVES * 64), LDS_BYTES, stream, a); }
    }
}
```

```cpp
#define REP_MASK 0u
#define REP_PAIR 0
#include <hip/hip_runtime.h>
#include <cstdio>
#include <cstdint>
namespace pg8 {
#define PG8_LAS __attribute__((address_space(3)))
typedef unsigned short bf16_t;
typedef short bf16x8 __attribute__((ext_vector_type(8)));
typedef float f32x4 __attribute__((ext_vector_type(4)));
typedef unsigned u32x4 __attribute__((ext_vector_type(4)));
constexpr int BM = 256, BK = 64, HALF = 128, HTB = HALF * BK * 2  , STAGE_BYTES = 8 * HTB, NXCD = 8, WGM = 8;

__host__ __device__ __forceinline__ int lds_byte(int r, int c) { const int st = (r >> 4) * 2 + (c >> 5), rr = r & 15, cc = c & 31, ob = rr * 64 + cc * 2; return st * 1024 + (ob ^ (((ob >> 9) & 1) << 5)); }
__host__ __device__ __forceinline__ void stage_rc(int b, int& R, int& C) { const int st = b / 1024, sb = b % 1024, swz = sb ^ (((sb >> 9) & 1) << 5); R = (st >> 1) * 16 + swz / 64; C = (st & 1) * 32 + (swz % 64) / 2; }
__host__ __device__ __forceinline__ int perm32(int rho) { const int n = rho >> 4, i = rho & 15; return 8 * (i >> 2) + 4 * n + (i & 3); }

struct Unit { int pm, pn; };
struct Gemm { const bf16_t* A; const bf16_t* Bt; int M, N, K; };

struct StaticOrder {
    int nM, nN, nwg, G, c;
    __host__ __device__ void init(int M, int N, int G_, int c_) { nM = M / BM; nN = N / BM; nwg = nM * nN; G = G_; c = c_; }
    __host__ __device__ bool next(int i, Unit& u) const {
        const long L = (long)i * G + c; if (L >= nwg) return false;
        int wgid = (int)L; { const int q = nwg / NXCD, r = nwg % NXCD, xcd = wgid % NXCD, off = wgid / NXCD; wgid = (xcd < r ? xcd * (q + 1) : r * (q + 1) + (xcd - r) * q) + off; }
        const int nig = WGM * nN, gid = wgid / nig, fm = gid * WGM, gsz = (nM - fm) < WGM ? (nM - fm) : WGM;
        u.pm = fm + ((wgid % nig) % gsz); u.pn = (wgid % nig) / gsz; return true;
    }
    __device__ __forceinline__ void a_ready(const Unit&) const {}
    __device__ __forceinline__ void done(const Unit&) const {}
};

__device__ __forceinline__ unsigned cvt_pk_bf16(float lo, float hi) { unsigned r; asm volatile("v_cvt_pk_bf16_f32 %0, %1, %2" : "=v"(r) : "v"(lo), "v"(hi)); return r; }
typedef float f32x2 __attribute__((ext_vector_type(2)));
__device__ __forceinline__ f32x2 gelu_pk(f32x2 v) {
    const f32x2 av = __builtin_elementwise_abs(v), d = av * 0.2316418882f + 1.0f;
    f32x2 t; t.x = __builtin_amdgcn_rcpf(d.x); t.y = __builtin_amdgcn_rcpf(d.y);
    f32x2 q = t * 0.5307027145f + (-0.7265760135f); q = q * t + 0.7107068705f; q = q * t + (-0.142248368f); q = q * t + 0.127414796f; q = q * t;
    const f32x2 s = (v * v) * (-0.72134752044f);
    f32x2 e; e.x = __builtin_amdgcn_exp2f(s.x); e.y = __builtin_amdgcn_exp2f(s.y);
    const f32x2 m = v * (q * e), r = v - m;
    f32x2 o; o.x = v.x < 0.f ? m.x : r.x; o.y = v.y < 0.f ? m.y : r.y; return o;
}

template <int ACT  > struct EpiBf16 {
    static constexpr bool PERM = true, AFTER_DRAIN = false; static_assert(ACT == 0 || ACT == 1, "EpiBf16: ACT is 0 (none) or 1 (gelu_pk)");
    bf16_t* O; int ldc; const float* bias; int split_cols; size_t split_stride; float scale0;
    __device__ __forceinline__ void operator()(const f32x4 (&acc)[2][2][4][2], const Unit& u, int wr, int wc, int fr, int fq) const {
        const int row0 = u.pm * BM + wr * 64 + fr; int colt = u.pn * BM; bf16_t* base = O;
        float sc = 1.f; if (split_cols) { const int t = colt / split_cols; base += (size_t)t * split_stride; colt -= t * split_cols; if (t == 0) sc = scale0; }
        const int col0 = colt + wc * 32 + 8 * fq, bcol0 = u.pn * BM + wc * 32 + 8 * fq;
        f32x4 bv[2][2];
#pragma unroll
        for (int bj = 0; bj < 2; ++bj)
#pragma unroll
            for (int n = 0; n < 2; ++n) bv[bj][n] = bias ? *(const f32x4*)(bias + bcol0 + bj * HALF + 4 * n) : (f32x4){0.f, 0.f, 0.f, 0.f};
#pragma unroll
        for (int ai = 0; ai < 2; ++ai)
#pragma unroll
            for (int m = 0; m < 4; ++m) { bf16_t* rowp = base + (size_t)(row0 + ai * HALF + m * 16) * ldc + col0;
#pragma unroll
                for (int bj = 0; bj < 2; ++bj) { f32x4 v0 = acc[ai][bj][m][0] + bv[bj][0], v1 = acc[ai][bj][m][1] + bv[bj][1];
                    if (ACT == 1) { f32x2 a = gelu_pk((f32x2){v0[0], v0[1]}), b = gelu_pk((f32x2){v0[2], v0[3]}), c = gelu_pk((f32x2){v1[0], v1[1]}), d = gelu_pk((f32x2){v1[2], v1[3]});
                        v0 = (f32x4){a.x, a.y, b.x, b.y}; v1 = (f32x4){c.x, c.y, d.x, d.y}; }
                    v0 = v0 * sc; v1 = v1 * sc; u32x4 w; w.x = cvt_pk_bf16(v0[0], v0[1]); w.y = cvt_pk_bf16(v0[2], v0[3]); w.z = cvt_pk_bf16(v1[0], v1[1]); w.w = cvt_pk_bf16(v1[2], v1[3]);
                    *(u32x4*)(rowp + bj * HALF) = w; } }
    }
};
__device__ __forceinline__ u32x4 pack8(const f32x4 v0, const f32x4 v1) { u32x4 w; w.x = cvt_pk_bf16(v0[0], v0[1]); w.y = cvt_pk_bf16(v0[2], v0[3]); w.z = cvt_pk_bf16(v1[0], v1[1]); w.w = cvt_pk_bf16(v1[2], v1[3]); return w; }
struct EpiCV {
    static constexpr bool PERM = true, AFTER_DRAIN = false;
    bf16_t* U; bf16_t* BG;
    __device__ __forceinline__ void operator()(const f32x4 (&acc)[2][2][4][2], const Unit& u, int wr, int wc, int fr, int fq) const {
        const int row0 = u.pm * BM + wr * 64 + fr;
        if (u.pn < 8) {
            const int col0 = u.pn * 128 + wc * 32 + 8 * fq;
#pragma unroll
            for (int ai = 0; ai < 2; ++ai)
#pragma unroll
                for (int m = 0; m < 4; ++m) { bf16_t* rowp = U + (size_t)(row0 + ai * HALF + m * 16) * 1024 + col0;
                    *(u32x4*)rowp = pack8(acc[ai][0][m][0] * acc[ai][1][m][0], acc[ai][0][m][1] * acc[ai][1][m][1]); }
        } else {
            const int col0 = (u.pn - 8) * 256 + wc * 32 + 8 * fq;
#pragma unroll
            for (int ai = 0; ai < 2; ++ai)
#pragma unroll
                for (int m = 0; m < 4; ++m) { bf16_t* rowp = BG + (size_t)(row0 + ai * HALF + m * 16) * 1024 + col0;
#pragma unroll
                    for (int bj = 0; bj < 2; ++bj) *(u32x4*)(rowp + bj * HALF) = pack8(acc[ai][bj][m][0], acc[ai][bj][m][1]); }
        }
    }
};
struct EpiRes {
    static constexpr bool PERM = false, AFTER_DRAIN = false;
    const float* xin; float* out; const float* gate; int gstride; int rows_per_batch; float alpha;
    __device__ __forceinline__ void operator()(const f32x4 (&acc)[2][2][4][2], const Unit& u, int wr, int wc, int fr, int fq) const {
        const int row0 = u.pm * BM + wr * 64 + fr, col0 = u.pn * BM + wc * 32 + 4 * fq;
        const int b = (u.pm * BM) / rows_per_batch;
        const float* gp = gate + (size_t)b * gstride + col0;
        const unsigned off0 = (unsigned)row0 * 1024u + (unsigned)col0;
#pragma unroll
        for (int bj = 0; bj < 2; ++bj)
#pragma unroll
            for (int n = 0; n < 2; ++n) { const f32x4 gv = *(const f32x4*)(gp + bj * HALF + n * 16) + 1.0f;
#pragma unroll
                for (int ai = 0; ai < 2; ++ai)
#pragma unroll
                    for (int m = 0; m < 4; ++m) { const unsigned off = off0 + (unsigned)((ai * HALF + m * 16) * 1024 + bj * HALF + n * 16);
                        const f32x4 xv = *(const f32x4*)(xin + off);
                        *(f32x4*)(out + off) = xv * alpha + gv * acc[ai][bj][m][n]; }
                asm volatile("" ::: "memory"); }
    }
};
__device__ __forceinline__ float silu_f(float x) { return x * __builtin_amdgcn_rcpf(1.0f + __builtin_amdgcn_exp2f(-1.4426950408889634f * x)); }
struct EpiMoeUp {
    static constexpr bool PERM = true, AFTER_DRAIN = false;
    bf16_t* HE;
    __device__ __forceinline__ void operator()(const f32x4 (&acc)[2][2][4][2], const Unit& u, int wr, int wc, int fr, int fq) const {
        const int row0 = u.pm * BM + wr * 64 + fr, col0 = (u.pn & 1) * 128 + wc * 32 + 8 * fq;
#pragma unroll
        for (int ai = 0; ai < 2; ++ai)
#pragma unroll
            for (int m = 0; m < 4; ++m) { f32x4 h0, h1;
#pragma unroll
                for (int j = 0; j < 4; ++j) { h0[j] = silu_f(acc[ai][0][m][0][j]) * acc[ai][1][m][0][j]; h1[j] = silu_f(acc[ai][0][m][1][j]) * acc[ai][1][m][1][j]; }
                *(u32x4*)(HE + (size_t)(row0 + ai * HALF + m * 16) * 256 + col0) = pack8(h0, h1); }
    }
};
struct EpiMoeDown {
    static constexpr bool PERM = true, AFTER_DRAIN = false;
    const int* slotp; const float* slotw; bf16_t* Y2;
    __device__ __forceinline__ void operator()(const f32x4 (&acc)[2][2][4][2], const Unit& u, int wr, int wc, int fr, int fq) const {
        const int row0 = u.pm * BM + wr * 64 + fr, col0 = (u.pn & 3) * 256 + wc * 32 + 8 * fq;
#pragma unroll
        for (int ai = 0; ai < 2; ++ai)
#pragma unroll
            for (int m = 0; m < 4; ++m) { const int slot = row0 + ai * HALF + m * 16; const int pair = slotp[slot]; const float w = slotw[slot];
                if (pair >= 0) { const unsigned off = (unsigned)pair * 1024u + (unsigned)col0;
#pragma unroll
                    for (int bj = 0; bj < 2; ++bj) *(u32x4*)(Y2 + off + bj * HALF) = pack8(acc[ai][bj][m][0] * w, acc[ai][bj][m][1] * w); }
                if (m & 1) asm volatile("" ::: "memory"); }
    }
};
struct MoeSched {
    const int* te; int ntiles; int nNt; int G, c;
    __device__ __forceinline__ bool next(int i, Unit& u) const {
        const long L = (long)i * G + c; if (L >= (long)ntiles * nNt) return false;
        const int T = (int)(L / nNt), q = (int)(L % nNt);
        const int e = __builtin_amdgcn_readfirstlane(te[T]);
        u.pm = T; u.pn = e * nNt + q; return true;
    }
    __device__ __forceinline__ void a_ready(const Unit&) const {}
    __device__ __forceinline__ void done(const Unit&) const {}
};

struct MoeTab { const PG8_LAS int* tb; const PG8_LAS int* cn; const PG8_LAS int* te; const int* list; };
struct MoeSchedG {
    MoeTab t; int ntiles; int nNt; int G, c;
    __device__ __forceinline__ bool next(int i, Unit& u) const {
        const long L = (long)i * G + c; if (L >= (long)ntiles * nNt) return false;
        const int T = (int)(L / nNt), q = (int)(L % nNt);
        const int e = __builtin_amdgcn_readfirstlane(t.te[T]);
        u.pm = T; u.pn = e * nNt + q; return true;
    }
    __device__ __forceinline__ int arow(const Unit& u, int r) const {
        const int e = u.pn / nNt; const int pos = (u.pm - t.tb[e]) * 256 + r; const int p = pos < t.cn[e] ? pos : 0;
        return t.list[(size_t)e * 65536 + p] >> 1;
    }
    __device__ __forceinline__ void a_ready(const Unit&) const {}
    __device__ __forceinline__ void done(const Unit&) const {}
};
struct RouteT4 { int e0, e1; float w0, w1; };
struct EpiMoeDown2 {
    static constexpr bool PERM = true, AFTER_DRAIN = false;
    MoeTab t; const RouteT4* rt; bf16_t* Y2;
    __device__ __forceinline__ void operator()(const f32x4 (&acc)[2][2][4][2], const Unit& u, int wr, int wc, int fr, int fq) const {
        const int e = u.pn >> 2, col0 = (u.pn & 3) * 256 + wc * 32 + 8 * fq;
        const int pos0 = (u.pm - t.tb[e]) * 256 + wr * 64 + fr, ce = t.cn[e];
#pragma unroll
        for (int ai = 0; ai < 2; ++ai)
#pragma unroll
            for (int m = 0; m < 4; ++m) { const int pos = pos0 + ai * HALF + m * 16;
                if (pos < ce) { const int pair = t.list[(size_t)e * 65536 + pos]; const RouteT4 r = rt[pair >> 1]; const float w = (pair & 1) ? r.w1 : r.w0;
                    const unsigned off = (unsigned)pair * 1024u + (unsigned)col0;
#pragma unroll
                    for (int bj = 0; bj < 2; ++bj) *(u32x4*)(Y2 + off + bj * HALF) = pack8(acc[ai][bj][m][0] * w, acc[ai][bj][m][1] * w); }
                if (m & 1) asm volatile("" ::: "memory"); }
    }
};
template <class Epi, class Sched, bool ALIGN_EPI = false, bool SP2 = false, bool GATHER = false>
__device__ __forceinline__ void gemm_phase(PG8_LAS unsigned char* lds, const Gemm g, const Sched& S, const Epi& E) {
    const int tid = threadIdx.x, wid = __builtin_amdgcn_readfirstlane(tid >> 6), lane = tid & 63, wr = wid >> 2, wc = wid & 3, fr = lane & 15, fq = lane >> 4;
    const int K = g.K, nt = K / BK;
    unsigned voffA[2], voffB[2];
#pragma unroll
    for (int i = 0; i < 2; ++i) { int R, C; stage_rc(tid * 16 + i * 8192, R, C); const int Rb = Epi::PERM ? ((R & ~31) + perm32(R & 31)) : R;
        voffA[i] = (unsigned)(R * K + C) * 2u; voffB[i] = (unsigned)(Rb * K + C) * 2u; }
    unsigned vA[2][2] = {{0u, 0u}, {0u, 0u}}, vN[2][2] = {{0u, 0u}, {0u, 0u}}; int gR[2], gC[2];
#pragma unroll
    for (int i = 0; i < 2; ++i) stage_rc(tid * 16 + i * 8192, gR[i], gC[i]);
    static_assert(!GATHER || SP2, "GATHER is wired into the SP2 loop only");
    const size_t kstep = (size_t)(BK * 2);
    const size_t hstep = (size_t)HALF * K * 2;
    const size_t tstep = 2 * hstep;
    const unsigned ldsw = (unsigned)wid * 1024u;
    const int aoff = lds_byte(wr * 64 + fr, fq * 8), boff = lds_byte(wc * 32 + fr, fq * 8);
#define PG8_SA(b, h) (((b) * 2 + (h)) * HTB)
#define PG8_SB(b, h) ((4 + (b) * 2 + (h)) * HTB)
#define PG8_STAGE(bufoff, gbase, voff) do { _Pragma("unroll") for (int _i = 0; _i < 2; ++_i) \
        __builtin_amdgcn_global_load_lds((const unsigned*)((const char*)(gbase) + (voff)[_i]), (PG8_LAS unsigned*)(lds + (bufoff) + ldsw + _i * 8192), 16, 0, 0); } while (0)
#define PG8_STAGEA(bufoff, abase, h, nx) do { if constexpr (GATHER) { _Pragma("unroll") for (int _i = 0; _i < 2; ++_i) \
        __builtin_amdgcn_global_load_lds((const unsigned*)((const char*)(abase) + ((nx) ? vN[h][_i] : vA[h][_i])), (PG8_LAS unsigned*)(lds + (bufoff) + ldsw + _i * 8192), 16, 0, 0); } \
        else { PG8_STAGE(bufoff, (abase) + ((h) ? hstep : (size_t)0), voffA); } } while (0)
#define PG8_GROWS(dst, u) do { _Pragma("unroll") for (int _h = 0; _h < 2; ++_h) _Pragma("unroll") for (int _i = 0; _i < 2; ++_i) dst[_h][_i] = (unsigned)S.arow(u, _h * HALF + gR[_i]) * (unsigned)(K * 2) + (unsigned)(gC[_i] * 2); } while (0)
#define PG8_LDA(dst, b, h) do { _Pragma("unroll") for (int m = 0; m < 4; ++m) _Pragma("unroll") for (int k = 0; k < 2; ++k) dst[m][k] = *(const PG8_LAS bf16x8*)(lds + PG8_SA(b, h) + aoff + m * 2048 + k * 1024); } while (0)
#define PG8_LDB(dst, b, h) do { _Pragma("unroll") for (int n = 0; n < 2; ++n) _Pragma("unroll") for (int k = 0; k < 2; ++k) dst[n][k] = *(const PG8_LAS bf16x8*)(lds + PG8_SB(b, h) + boff + n * 2048 + k * 1024); } while (0)
#define PG8_MMA(ai, bj, At, Bt) do { __builtin_amdgcn_s_setprio(1); _Pragma("unroll") for (int m = 0; m < 4; ++m) _Pragma("unroll") for (int n = 0; n < 2; ++n) _Pragma("unroll") for (int k = 0; k < 2; ++k) \
        acc[ai][bj][m][n] = __builtin_amdgcn_mfma_f32_16x16x32_bf16(Bt[n][k], At[m][k], acc[ai][bj][m][n], 0, 0, 0); __builtin_amdgcn_s_setprio(0); } while (0)
#define PG8_WAIT_V(n) asm volatile("s_waitcnt vmcnt(" #n ")" ::: "memory")
#define PG8_WAIT_L(n) asm volatile("s_waitcnt lgkmcnt(" #n ")" ::: "memory")
#define PG8_BAR __builtin_amdgcn_s_barrier()
#define PG8_SCHED __builtin_amdgcn_sched_barrier(0)
    Unit cur, nxt; int ui = 0;
    if (!S.next(0, cur)) return;
    f32x4 acc[2][2][4][2];
#pragma unroll
    for (int a = 0; a < 2; ++a)
#pragma unroll
        for (int b = 0; b < 2; ++b)
#pragma unroll
            for (int m = 0; m < 4; ++m)
#pragma unroll
                for (int n = 0; n < 2; ++n) acc[a][b][m][n] = (f32x4){0.f, 0.f, 0.f, 0.f};
    bf16x8 At[4][2], B0[2][2], B1[2][2];
    const char* cA = GATHER ? (const char*)g.A : (const char*)g.A + (size_t)cur.pm * tstep; const char* cB = (const char*)g.Bt + (size_t)cur.pn * tstep;
    S.a_ready(cur);
    if constexpr (GATHER) { PG8_GROWS(vA, cur); }
    if constexpr (SP2) {
        PG8_STAGE(PG8_SB(0, 0), cB, voffB); PG8_STAGE(PG8_SB(0, 1), cB + hstep, voffB); PG8_STAGEA(PG8_SA(0, 0), cA, 0, false); PG8_STAGEA(PG8_SA(0, 1), cA, 1, false);
        if (wr == 1) PG8_BAR;
        PG8_WAIT_V(2); PG8_BAR;
        PG8_STAGE(PG8_SB(1, 0), cB + kstep, voffB); PG8_STAGEA(PG8_SA(1, 0), cA + kstep, 0, false); PG8_STAGE(PG8_SB(1, 1), cB + hstep + kstep, voffB);
        PG8_WAIT_V(6); PG8_BAR;
    } else {
        PG8_STAGE(PG8_SB(0, 0), cB, voffB); PG8_STAGE(PG8_SA(0, 0), cA, voffA); PG8_STAGE(PG8_SB(0, 1), cB + hstep, voffB); PG8_STAGE(PG8_SA(0, 1), cA + hstep, voffA);
        if (wr == 1) PG8_BAR;
        PG8_WAIT_V(4); PG8_BAR;
        PG8_STAGE(PG8_SB(1, 0), cB + kstep, voffB); PG8_STAGE(PG8_SA(1, 0), cA + kstep, voffA); PG8_STAGE(PG8_SB(1, 1), cB + hstep + kstep, voffB);
        PG8_WAIT_V(6); PG8_BAR;
    }
    for (;;) {
        const bool has_next = S.next(ui + 1, nxt);
        const char* nA = GATHER ? cA : (has_next ? (const char*)g.A + (size_t)nxt.pm * tstep : cA);
        if constexpr (GATHER) { if (has_next) { PG8_GROWS(vN, nxt); } else { _Pragma("unroll") for (int _h = 0; _h < 2; ++_h) _Pragma("unroll") for (int _i = 0; _i < 2; ++_i) vN[_h][_i] = vA[_h][_i]; } } const char* nB = has_next ? (const char*)g.Bt + (size_t)nxt.pn * tstep : cB;
        for (int t = 0; t < nt; t += 2) {
            const bool last = (t == nt - 2);
            const char* a1 = cA + (size_t)(t + 1) * kstep;
            const char* a2 = last ? nA : cA + (size_t)(t + 2) * kstep; const char* b2 = last ? nB : cB + (size_t)(t + 2) * kstep;
            const char* a3 = a2 + kstep; const char* b3 = b2 + kstep;
            if (last && has_next) S.a_ready(nxt);
            if constexpr (SP2) {
            PG8_LDB(B0, 0, 0); PG8_LDB(B1, 0, 1); PG8_SCHED; PG8_LDA(At, 0, 0); PG8_STAGEA(PG8_SA(1, 1), a1, 1, false);
            PG8_WAIT_V(8); PG8_WAIT_L(0); PG8_BAR; PG8_MMA(0, 0, At, B0); PG8_MMA(0, 1, At, B1); PG8_BAR; PG8_SCHED;
            PG8_LDA(At, 0, 1); PG8_STAGE(PG8_SB(0, 0), b2, voffB); PG8_STAGE(PG8_SB(0, 1), b2 + hstep, voffB); PG8_STAGEA(PG8_SA(0, 0), a2, 0, last);
            PG8_WAIT_V(8); PG8_WAIT_L(0); PG8_BAR; PG8_MMA(1, 0, At, B0); PG8_MMA(1, 1, At, B1); PG8_BAR; PG8_SCHED;
            PG8_LDB(B0, 1, 0); PG8_LDB(B1, 1, 1); PG8_SCHED; PG8_LDA(At, 1, 0); PG8_STAGEA(PG8_SA(0, 1), a2, 1, last);
            PG8_WAIT_V(8); PG8_WAIT_L(0); PG8_BAR; PG8_MMA(0, 0, At, B0); PG8_MMA(0, 1, At, B1); PG8_BAR; PG8_SCHED;
            PG8_LDA(At, 1, 1); PG8_STAGE(PG8_SB(1, 0), b3, voffB); PG8_STAGE(PG8_SB(1, 1), b3 + hstep, voffB); PG8_STAGEA(PG8_SA(1, 0), a3, 0, last);
            PG8_WAIT_V(8); PG8_WAIT_L(0); PG8_BAR; PG8_MMA(1, 0, At, B0); PG8_MMA(1, 1, At, B1); PG8_BAR; PG8_SCHED;
            } else {
            PG8_LDB(B0, 0, 0); PG8_SCHED; PG8_LDA(At, 0, 0); PG8_STAGE(PG8_SA(1, 1), a1 + hstep, voffA);
            PG8_WAIT_L(8); PG8_BAR; PG8_WAIT_L(0); PG8_MMA(0, 0, At, B0); PG8_BAR; PG8_SCHED;
            PG8_LDB(B1, 0, 1); PG8_STAGE(PG8_SB(0, 0), b2, voffB);
            PG8_BAR; PG8_WAIT_L(0); PG8_MMA(0, 1, At, B1); PG8_BAR;
            PG8_LDA(At, 0, 1); PG8_STAGE(PG8_SA(0, 0), a2, voffA);
            PG8_BAR; PG8_WAIT_L(0); PG8_MMA(1, 0, At, B0); PG8_BAR; PG8_SCHED;
            PG8_STAGE(PG8_SB(0, 1), b2 + hstep, voffB);
            PG8_WAIT_V(6); PG8_BAR; PG8_MMA(1, 1, At, B1); PG8_BAR;
            PG8_LDB(B0, 1, 0); PG8_SCHED; PG8_LDA(At, 1, 0); PG8_STAGE(PG8_SA(0, 1), a2 + hstep, voffA);
            PG8_WAIT_L(8); PG8_BAR; PG8_WAIT_L(0); PG8_MMA(0, 0, At, B0); PG8_BAR; PG8_SCHED;
            PG8_LDB(B1, 1, 1); PG8_STAGE(PG8_SB(1, 0), b3, voffB);
            PG8_BAR; PG8_WAIT_L(0); PG8_MMA(0, 1, At, B1); PG8_BAR;
            PG8_LDA(At, 1, 1); PG8_STAGE(PG8_SA(1, 0), a3, voffA);
            PG8_BAR; PG8_WAIT_L(0); PG8_MMA(1, 0, At, B0); PG8_BAR; PG8_SCHED;
            PG8_STAGE(PG8_SB(1, 1), b3 + hstep, voffB);
            PG8_WAIT_V(6); PG8_BAR; PG8_MMA(1, 1, At, B1); PG8_BAR;
            }
        }
        if constexpr (ALIGN_EPI) { if (wr == 0) PG8_BAR; }
        if constexpr (!Epi::AFTER_DRAIN) { E(acc, cur, wr, wc, fr, fq); S.done(cur); }
        if (!has_next) break;
#pragma unroll
        for (int a = 0; a < 2; ++a)
#pragma unroll
            for (int b = 0; b < 2; ++b)
#pragma unroll
                for (int m = 0; m < 4; ++m)
#pragma unroll
                    for (int n = 0; n < 2; ++n) acc[a][b][m][n] = (f32x4){0.f, 0.f, 0.f, 0.f};
        cur = nxt; cA = nA; cB = nB; ++ui;
        if constexpr (GATHER) { _Pragma("unroll") for (int _h = 0; _h < 2; ++_h) _Pragma("unroll") for (int _i = 0; _i < 2; ++_i) vA[_h][_i] = vN[_h][_i]; }
        if constexpr (ALIGN_EPI) { if (wr == 1) PG8_BAR; }
    }
    PG8_WAIT_V(0);
    if constexpr (!ALIGN_EPI) { if (wr == 0) PG8_BAR; }
    PG8_BAR;
    if constexpr (Epi::AFTER_DRAIN) { E.fused(acc, cur, wr, wc, fr, fq, lds, wid, lane); S.done(cur); }
#undef PG8_SA
#undef PG8_SB
#undef PG8_STAGE
#undef PG8_STAGEA
#undef PG8_GROWS
#undef PG8_LDA
#undef PG8_LDB
#undef PG8_MMA
#undef PG8_WAIT_V
#undef PG8_WAIT_L
#undef PG8_BAR
#undef PG8_SCHED
}
}
#define GAS __attribute__((address_space(1)))
#define LAS __attribute__((address_space(3)))
typedef unsigned short bf16;
typedef unsigned v4u __attribute__((ext_vector_type(4)));
typedef float f32x4 __attribute__((ext_vector_type(4)));
typedef short bf16x8 __attribute__((ext_vector_type(8)));
typedef GAS unsigned gu32;
typedef GAS unsigned long long gu64;
#define RLX_AGENT __ATOMIC_RELAXED, __HIP_MEMORY_SCOPE_AGENT
#define LDS_WAIT() asm volatile("s_waitcnt lgkmcnt(0)" ::: "memory")
#define VM_WAIT() asm volatile("s_waitcnt vmcnt(0)" ::: "memory")
__device__ __forceinline__ unsigned long long rt() { return __builtin_amdgcn_s_memrealtime(); }
__device__ __forceinline__ unsigned f2bf(float f) { unsigned u = __builtin_bit_cast(unsigned, f); return (u + 0x7fffu + ((u >> 16) & 1u)) >> 16; }
__device__ __forceinline__ unsigned pk2(float lo, float hi) { return f2bf(lo) | (f2bf(hi) << 16); }

#define XB_TMO      128
#define XB_XCNT(j)  (256  + 64 * (j))
#define XB_XSUB(j)  (1280 + 64 * (j))
#define XB_XGEN(j)  (2304 + 64 * (j))
#define XB_TOP      3328
#define XB_TOPGEN   3392
#define XCD_BAR_WORDS 3456
#define XB_SPIN_CAP (1u << 18)

__device__ __forceinline__ unsigned xb_ld(unsigned* p)              { return __hip_atomic_load(p, __ATOMIC_RELAXED, __HIP_MEMORY_SCOPE_AGENT); }
__device__ __forceinline__ unsigned xb_add(unsigned* p, unsigned v) { return __hip_atomic_fetch_add(p, v, __ATOMIC_RELAXED, __HIP_MEMORY_SCOPE_AGENT); }
__device__ __forceinline__ unsigned xb_xcc_id() { return (unsigned)__builtin_amdgcn_s_getreg((3 << 11) | 20) & 0xFu; }
#define XB_SPIN(cond, bar) do { unsigned _sp = 0; while (cond) { __builtin_amdgcn_s_sleep(1); \
    if ((++_sp & 255u) == 0u) { if (xb_ld(&(bar)[XB_TMO])) break; if (_sp > XB_SPIN_CAP) { atomicAdd(&(bar)[XB_TMO], 1u); break; } } } } while (0)

struct XcdBarrier {
    unsigned* bar; unsigned x;
    volatile LAS unsigned* st;
};

__device__ __forceinline__ XcdBarrier xcd_barrier_post(unsigned* bar, volatile LAS unsigned* st) {
    XcdBarrier b; b.bar = bar; b.x = xb_xcc_id(); b.st = st;
    if (threadIdx.x == 0) (void)xb_add(&bar[XB_XCNT(b.x)], 1u);
    return b;
}
__device__ __forceinline__ void xcd_barrier_complete(unsigned* bar, unsigned x, unsigned& nloc, unsigned& nx) {
    const unsigned G = gridDim.x * gridDim.y * gridDim.z;
    unsigned sum, cnt, mine, sp = 0u;
    for (;;) {
        sum = 0u; cnt = 0u; mine = 0u;
#pragma unroll
        for (unsigned j = 0; j < 16; ++j) { const unsigned c = xb_ld(&bar[XB_XCNT(j)]); sum += c; cnt += (c > 0u) ? 1u : 0u; mine = (j == x) ? c : mine; }
        if (sum == G) break;
        __builtin_amdgcn_s_sleep(1);
        if ((++sp & 255u) == 0u) { if (xb_ld(&bar[XB_TMO])) break; if (sp > XB_SPIN_CAP) { atomicAdd(&bar[XB_TMO], 1u); break; } }
    }
    nloc = mine > 0u ? mine : 1u; nx = cnt > 0u ? cnt : 1u;
}

__device__ __forceinline__ void xcd_barrier(const XcdBarrier& b) {
    asm volatile("s_waitcnt vmcnt(0)" ::: "memory");
    __syncthreads();
    if (threadIdx.x == 0) {
        unsigned* bar = b.bar;
        __builtin_amdgcn_s_waitcnt(0);
        unsigned nloc = b.st[0], nx = b.st[1];
        if (nloc == 0u) { xcd_barrier_complete(bar, b.x, nloc, nx); b.st[0] = nloc; b.st[1] = nx; }
        const unsigned old = xb_add(&bar[XB_XSUB(b.x)], 1u);
        const unsigned gen = old / nloc;
        if (old + 1u == (gen + 1u) * nloc) {
            __builtin_amdgcn_fence(__ATOMIC_RELEASE, "agent");
            asm volatile("s_waitcnt vmcnt(0)" ::: "memory");
            const unsigned og = xb_add(&bar[XB_TOP], 1u);
            const unsigned tg = og / nx;
            if (og + 1u == (tg + 1u) * nx) xb_add(&bar[XB_TOPGEN], 1u);
            else XB_SPIN(xb_ld(&bar[XB_TOPGEN]) == tg, bar);
            __builtin_amdgcn_fence(__ATOMIC_ACQUIRE, "agent");
            xb_add(&bar[XB_XGEN(b.x)], 1u);
            asm volatile("s_waitcnt vmcnt(0)" ::: "memory");
        } else {
            XB_SPIN(xb_ld(&bar[XB_XGEN(b.x)]) == gen, bar);
            __builtin_amdgcn_fence(__ATOMIC_ACQUIRE, "agent");
            asm volatile("s_waitcnt vmcnt(0)" ::: "memory");
        }
    }
    __syncthreads();
}

constexpr int NWAVES = 8;
constexpr int NPHASE = 22;
#ifndef MK_N_LAUNCHES
#define MK_N_LAUNCHES 1
#endif
constexpr int N_LAUNCHES = MK_N_LAUNCHES;

constexpr int BATCH = 4, SEQ = 8192, D = 1024, M = BATCH * SEQ, QW = 3072, NE = 16, FF = 256, HD = 128;
constexpr int HALF_ROWS = M / 2;
constexpr float LN_EPS = 1e-5f, ALPHA = 1.4142135623730951f;
constexpr float LOG2E = 1.4426950408889634f, LN2 = 0.6931471805599453f;
constexpr int ADA_STRIDE = 14336;

constexpr size_t MiB = 1u << 20;
constexpr size_t WS_CTL = 0, CTL_ZERO_BYTES = 1 * MiB;
constexpr size_t WS_TAB = 1 * MiB;
constexpr size_t TAB_ADA = 0, TAB_BT = 256 * 1024, TAB_TE = 320 * 1024, TAB_NT = 328 * 1024;
constexpr size_t WS_WIN = 2 * MiB, WS_WOUT = 8 * MiB, WS_WKV = 10 * MiB, WS_WQ = 22 * MiB, WS_WO = 28 * MiB, WS_WGU = 30 * MiB, WS_WD = 62 * MiB;
constexpr size_t WS_H = 78 * MiB;
constexpr size_t WS_U = 142 * MiB, WS_BG = 206 * MiB;
constexpr size_t WS_HKV = 142 * MiB;
constexpr size_t WS_K = 206 * MiB, WS_V = 302 * MiB, WS_Q = 398 * MiB, WS_LSE = 494 * MiB;
constexpr size_t WS_RT = 504 * MiB, WS_LIST = 505 * MiB, WS_SLOTP = 510 * MiB, WS_SLOTW = 511 * MiB;
constexpr size_t WS_END = 512 * MiB;
constexpr size_t WS_HS0 = 142 * MiB, WS_HE0 = 278 * MiB, WS_Y20 = 312 * MiB, MOE_LSTEP = 64 * MiB;
constexpr int MAXTILES = 272;
constexpr int CW_TMO = 0, CW_BAR = 4096, CW_CNT = 16384;

constexpr int RING_OFF = 0, RING_BYTES = 131072;
constexpr int LDSCTL_OFF = RING_BYTES, MISC_OFF = LDSCTL_OFF + 320;
constexpr int LDS_BYTES = 147456;

__device__ const unsigned char T5_BUCKET[3][129] = {
{0,1,2,3,4,5,6,7,8,9,10,11,12,13,14,15,16,16,16,16,16,16,17,17,17,17,17,17,17,17,18,18,18,18,18,18,18,18,18,18,19,19,19,19,19,19,19,19,19,19,19,19,19,19,20,20,20,20,20,20,20,20,20,20,20,20,20,20,20,20,20,20,20,21,21,21,21,21,21,21,21,21,21,21,21,21,21,21,21,21,21,21,21,21,21,21,21,21,21,22,22,22,22,22,22,22,22,22,22,22,22,22,22,22,22,22,22,22,22,22,22,22,22,22,22,22,22,22,22},
{0,4,8,12,16,16,17,17,18,18,19,19,19,19,20,20,20,20,20,21,21,21,21,21,21,22,22,22,22,22,22,22,22,22,23,23,23,23,23,23,23,23,23,23,23,23,24,24,24,24,24,24,24,24,24,24,24,24,24,24,24,24,25,25,25,25,25,25,25,25,25,25,25,25,25,25,25,25,25,25,25,25,25,26,26,26,26,26,26,26,26,26,26,26,26,26,26,26,26,26,26,26,26,26,26,26,26,26,26,26,26,26,26,27,27,27,27,27,27,27,27,27,27,27,27,27,27,27,27},
{0,16,18,19,20,21,21,22,22,23,23,23,24,24,24,24,25,25,25,25,25,26,26,26,26,26,26,26,26,27,27,27,27,27,27,27,27,27,27,28,28,28,28,28,28,28,28,28,28,28,28,28,29,29,29,29,29,29,29,29,29,29,29,29,29,29,29,29,29,29,30,30,30,30,30,30,30,30,30,30,30,30,30,30,30,30,30,30,30,30,30,30,30,30,30,31,31,31,31,31,31,31,31,31,31,31,31,31,31,31,31,31,31,31,31,31,31,31,31,31,31,31,31,31,31,31,31,31,31}};

struct Frame {
    LAS unsigned char* lds;
    volatile LAS unsigned* MISC;
    gu32* ctl;
    unsigned char* ws;
    int tid, lane, wave;
    int vcu, G;
    int gw, NGW;
};
typedef unsigned u32x2v __attribute__((ext_vector_type(2)));
typedef float f32x16 __attribute__((ext_vector_type(16)));
typedef short s16x4 __attribute__((ext_vector_type(4)));
typedef short v4i16_t __attribute__((ext_vector_type(4)));
typedef float f32x2_t __attribute__((ext_vector_type(2))); typedef __bf16 bf16x2_t __attribute__((ext_vector_type(2)));
__device__ __forceinline__ unsigned cvtpk_s(float lo, float hi) { f32x2_t v = {lo, hi}; bf16x2_t b = __builtin_convertvector(v, bf16x2_t); return __builtin_bit_cast(unsigned, b); }
__device__ __forceinline__ float bflo(unsigned w) { return __uint_as_float(w << 16); }
__device__ __forceinline__ float bfhi(unsigned w) { return __uint_as_float(w & 0xffff0000u); }
__device__ __forceinline__ float wave_sum(float v) {
#pragma unroll
    for (int o = 1; o < 64; o <<= 1) v += __shfl_xor(v, o);
    return v;
}

__device__ __forceinline__ void p0_transpose_item(const float* W, int ldw, int k0, int srccol0, bf16* WT, int ldt, int dstrow0, LAS float* scr, int lane) {
#pragma unroll 8
    for (int i = 0; i < 32; ++i) { const int kk = 2 * i + (lane >> 5); scr[kk * 33 + (lane & 31)] = W[(size_t)(k0 + kk) * ldw + srccol0 + (lane & 31)]; }
    LDS_WAIT(); asm volatile("" ::: "memory");
    const int c = lane & 7;
#pragma unroll
    for (int j = 0; j < 4; ++j) { const int n = (lane >> 3) + 8 * j; const LAS float* s = scr + (8 * c) * 33 + n;
        v4u o; o.x = pk2(s[0 * 33], s[1 * 33]); o.y = pk2(s[2 * 33], s[3 * 33]); o.z = pk2(s[4 * 33], s[5 * 33]); o.w = pk2(s[6 * 33], s[7 * 33]);
        *(GAS v4u*)(WT + (size_t)(dstrow0 + n) * ldt + k0 + 8 * c) = o; }
    LDS_WAIT(); asm volatile("" ::: "memory");
}
struct P0In { const float *c, *ada_w, *ada_b, *conv_w_in, *conv_w_out, *kv_ada_w, *kv_ada_b, *w_kv, *w_q, *w_o, *rel_bias, *wg, *wu, *wd; };
__device__ __forceinline__ void p0_prologue(Frame& F, const P0In& I) {
    {
        LAS float* cond = (LAS float*)(F.lds + RING_OFF);
        LAS float* part = (LAS float*)(F.lds + RING_OFF + 16384);
        for (int i = F.tid; i < BATCH * D; i += NWAVES * 64) { const float v = I.c[i]; cond[i] = v / (1.0f + __expf(-v)); }
        __syncthreads();
        for (int u = F.vcu; u < ADA_STRIDE / 64; u += F.G) {
            const int col = u * 64 + F.lane;
            const float* W; int ld, cc; const float* bias;
            if (col < 6144) { W = I.ada_w; ld = 6144; cc = col; bias = I.ada_b; }
            else if (col < 12288) { W = I.ada_w + (size_t)D * 6144; ld = 6144; cc = col - 6144; bias = I.ada_b + 6144; }
            else { W = I.kv_ada_w; ld = 2048; cc = col - 12288; bias = I.kv_ada_b; }
            float a0 = 0.f, a1 = 0.f, a2 = 0.f, a3 = 0.f;
            const int kb = F.wave * 128;
#pragma unroll 8
            for (int k = 0; k < 128; ++k) { const float w = W[(size_t)(kb + k) * ld + cc];
                a0 += cond[kb + k] * w; a1 += cond[1024 + kb + k] * w; a2 += cond[2048 + kb + k] * w; a3 += cond[3072 + kb + k] * w; }
            part[(F.wave * 4 + 0) * 64 + F.lane] = a0; part[(F.wave * 4 + 1) * 64 + F.lane] = a1; part[(F.wave * 4 + 2) * 64 + F.lane] = a2; part[(F.wave * 4 + 3) * 64 + F.lane] = a3;
            __syncthreads();
            if (F.wave < 4) { float s = bias[cc];
#pragma unroll
                for (int w = 0; w < 8; ++w) s += part[(w * 4 + F.wave) * 64 + F.lane];
                ((float*)(F.ws + WS_TAB + TAB_ADA))[(size_t)F.wave * ADA_STRIDE + col] = s; }
            __syncthreads();
        }
        for (int i = F.vcu * (NWAVES * 64) + F.tid; i < 3 * 8 * 129; i += F.G * NWAVES * 64) {
            const int g = i / (8 * 129), h = (i / 129) % 8, d = i % 129;
            ((float*)(F.ws + WS_TAB + TAB_BT))[i] = I.rel_bias[(int)T5_BUCKET[g][d] * 24 + g * 8 + h] * LOG2E;
        }
        __syncthreads();
    }
    LAS float* scr = (LAS float*)(F.lds + RING_OFF + F.wave * 16384);
    bf16* const Win = (bf16*)(F.ws + WS_WIN); bf16* const Wout = (bf16*)(F.ws + WS_WOUT); bf16* const Wkv = (bf16*)(F.ws + WS_WKV);
    bf16* const Wq = (bf16*)(F.ws + WS_WQ); bf16* const Wo = (bf16*)(F.ws + WS_WO); bf16* const Wgu = (bf16*)(F.ws + WS_WGU); bf16* const Wd = (bf16*)(F.ws + WS_WD);
    constexpr int I_IN = 16 * 96, I_OUT = 16 * 32, I_KV = 16 * 192, I_Q = 16 * 96, I_O = 16 * 32, I_GU = 32 * 256, I_D = 32 * 128;
    constexpr int NITEMS = I_IN + I_OUT + I_KV + I_Q + I_O + I_GU + I_D;
    for (int it = F.gw; it < NITEMS; it += F.NGW) {
        int r = it;
        if (r < I_IN) { const int kb = r / 96, nb = r % 96, n0 = 32 * nb; int src;
            if (n0 < 2048) { const int t = n0 >> 8, j = n0 & 255; src = (j < 128) ? (1024 + 128 * t + j) : (2048 + 128 * t + (j - 128)); } else src = n0 - 2048;
            p0_transpose_item(I.conv_w_in, 3072, 64 * kb, src, Win, 1024, n0, scr, F.lane); continue; } r -= I_IN;
        if (r < I_OUT) { const int kb = r / 32, nb = r % 32; p0_transpose_item(I.conv_w_out, 1024, 64 * kb, 32 * nb, Wout, 1024, 32 * nb, scr, F.lane); continue; } r -= I_OUT;
        if (r < I_KV) { const int kb = r / 192, nb = r % 192; p0_transpose_item(I.w_kv, 6144, 64 * kb, 32 * nb, Wkv, 1024, 32 * nb, scr, F.lane); continue; } r -= I_KV;
        if (r < I_Q) { const int kb = r / 96, nb = r % 96; p0_transpose_item(I.w_q, 3072, 64 * kb, 32 * nb, Wq, 1024, 32 * nb, scr, F.lane); continue; } r -= I_Q;
        if (r < I_O) { const int kb = r / 32, nb = r % 32; p0_transpose_item(I.w_o, 1024, 64 * kb, 32 * nb, Wo, 1024, 32 * nb, scr, F.lane); continue; } r -= I_O;
        if (r < I_GU) { const int le = r / 256, q = r % 256, kb = q / 16, nb = q % 16, n0 = 32 * nb, t = n0 >> 8, j = n0 & 255;
            const float* src = (j < 128) ? (I.wg + (size_t)le * 1024 * 256) : (I.wu + (size_t)le * 1024 * 256); const int sc = 128 * t + (j & 127);
            p0_transpose_item(src, 256, 64 * kb, sc, Wgu + (size_t)le * 512 * 1024, 1024, n0, scr, F.lane); continue; } r -= I_GU;
        { const int le = r / 128, q = r % 128, kb = q / 32, nb = q % 32;
            p0_transpose_item(I.wd + (size_t)le * 256 * 1024, 1024, 64 * kb, 32 * nb, Wd + (size_t)le * 1024 * 256, 256, 32 * nb, scr, F.lane); }
    }
}

__device__ __forceinline__ void store_mod_bf16(bf16* orow, const f32x4 (&v)[4], const float* shift, const float* scale, int lane) {
    GAS unsigned long long* o8 = (GAS unsigned long long*)orow + lane;
#pragma unroll
    for (int j = 0; j < 4; ++j) { const f32x4 sh = ((const f32x4*)shift)[lane + 64 * j], sc = ((const f32x4*)scale)[lane + 64 * j]; const f32x4 h = v[j] * (sc + 1.0f) + sh;
        o8[64 * j] = (unsigned long long)cvtpk_s(h[0], h[1]) | ((unsigned long long)cvtpk_s(h[2], h[3]) << 32); }
}
__device__ __forceinline__ void p1_mod0(Frame& F, const float* x) {
    const float* ada = (const float*)(F.ws + WS_TAB + TAB_ADA); bf16* H = (bf16*)(F.ws + WS_H);
    for (int row = F.gw; row < M; row += F.NGW) { const int b = row >> 13;
        f32x4 v[4];
#pragma unroll
        for (int j = 0; j < 4; ++j) v[j] = ((const f32x4*)(x + (size_t)row * D))[F.lane + 64 * j];
        store_mod_bf16(H + (size_t)row * D, v, ada + (size_t)b * ADA_STRIDE + 0, ada + (size_t)b * ADA_STRIDE + 1024, F.lane); }
}
__device__ __forceinline__ void p3_conv(Frame& F, const float* conv_w) {
    const bf16* U = (const bf16*)(F.ws + WS_U); const bf16* BG = (const bf16*)(F.ws + WS_BG); bf16* Z = (bf16*)(F.ws + WS_H);
    float w0[16], w1[16], w2[16];
#pragma unroll
    for (int j = 0; j < 2; ++j)
#pragma unroll
        for (int k = 0; k < 8; ++k) { const int col = 512 * j + 8 * F.lane + k; w0[8 * j + k] = conv_w[col]; w1[8 * j + k] = conv_w[1024 + col]; w2[8 * j + k] = conv_w[2048 + col]; }
    for (int run = F.gw; run < M / 16; run += F.NGW) {
        const int r0 = run * 16; const int t0 = r0 & (SEQ - 1);
        float um1[16], um2[16];
        if (t0 == 0) {
#pragma unroll
            for (int k = 0; k < 16; ++k) { um1[k] = 0.f; um2[k] = 0.f; }
        } else {
#pragma unroll
            for (int j = 0; j < 2; ++j) { const v4u a = *(const v4u*)(U + (size_t)(r0 - 1) * D + 512 * j + 8 * F.lane), b = *(const v4u*)(U + (size_t)(r0 - 2) * D + 512 * j + 8 * F.lane);
#pragma unroll
                for (int k = 0; k < 4; ++k) { um1[8 * j + 2 * k] = bflo(a[k]); um1[8 * j + 2 * k + 1] = bfhi(a[k]); um2[8 * j + 2 * k] = bflo(b[k]); um2[8 * j + 2 * k + 1] = bfhi(b[k]); } }
        }
#pragma unroll 4
        for (int i = 0; i < 16; ++i) { const size_t ro = (size_t)(r0 + i) * D;
#pragma unroll
            for (int j = 0; j < 2; ++j) { const v4u uu = *(const v4u*)(U + ro + 512 * j + 8 * F.lane), bb = *(const v4u*)(BG + ro + 512 * j + 8 * F.lane); v4u o;
#pragma unroll
                for (int k = 0; k < 4; ++k) { const int e0 = 8 * j + 2 * k, e1 = e0 + 1; const float u0 = bflo(uu[k]), u1 = bfhi(uu[k]);
                    const float z0 = bflo(bb[k]) * (w0[e0] * um2[e0] + w1[e0] * um1[e0] + w2[e0] * u0), z1 = bfhi(bb[k]) * (w0[e1] * um2[e1] + w1[e1] * um1[e1] + w2[e1] * u1);
                    um2[e0] = um1[e0]; um1[e0] = u0; um2[e1] = um1[e1]; um1[e1] = u1; o[k] = cvtpk_s(z0, z1); }
                *(v4u*)(Z + ro + 512 * j + 8 * F.lane) = o; } }
    }
}

struct RouteT { int e0, e1; float w0, w1; };
__device__ __forceinline__ void lnr_phase(Frame& F, int layer, float* X, bf16* H2, const float* ln_g, const float* ln_b, const float* router_w, const float* router_bias) {
    LAS float* RWt = (LAS float*)(F.lds + RING_OFF);
    LAS int* lcnt = (LAS int*)(F.lds + RING_OFF + 65536);
    LAS int* gbase = (LAS int*)(F.lds + RING_OFF + 65536 + 64);
    LAS int* ent = (LAS int*)(F.lds + RING_OFF + 65536 + 128);
    const float* ada = (const float*)(F.ws + WS_TAB + TAB_ADA) + layer * 6144;
    RouteT* RT = (RouteT*)(F.ws + WS_RT); int* LIST = (int*)(F.ws + WS_LIST);
    for (int idx = F.tid; idx < 16384; idx += NWAVES * 64) RWt[(idx & 15) * 1024 + (idx >> 4)] = router_w[idx];
    float rb[16];
#pragma unroll
    for (int e = 0; e < 16; ++e) rb[e] = router_bias[e];
    const float* gg = ln_g + (size_t)(layer * 2 + 0) * D; const float* gb = ln_b + (size_t)(layer * 2 + 0) * D;
    for (int rbk = F.vcu; rbk < M / 128; rbk += F.G) {
        if (F.tid < 16) lcnt[F.tid] = 0;
        __syncthreads();
        for (int it = 0; it < 16; ++it) {
            const int row = rbk * 128 + F.wave * 16 + it, b = row >> 13;
            f32x4 v[4]; float s = 0.f;
#pragma unroll
            for (int j = 0; j < 4; ++j) { v[j] = ((const f32x4*)(X + (size_t)row * D))[F.lane + 64 * j]; s += (v[j][0] + v[j][1]) + (v[j][2] + v[j][3]); }
            const float mean = wave_sum(s) * (1.f / D); float s2 = 0.f;
#pragma unroll
            for (int j = 0; j < 4; ++j) { v[j] = v[j] - mean; s2 += (v[j][0] * v[j][0] + v[j][1] * v[j][1]) + (v[j][2] * v[j][2] + v[j][3] * v[j][3]); }
            const float rstd = 1.f / sqrtf(wave_sum(s2) * (1.f / D) + LN_EPS);
            f32x4 hv[4];
            const float* shp = ada + (size_t)b * ADA_STRIDE + 3072; const float* scp = ada + (size_t)b * ADA_STRIDE + 4096;
            GAS unsigned long long* o8 = (GAS unsigned long long*)(H2 + (size_t)row * D) + F.lane;
#pragma unroll
            for (int j = 0; j < 4; ++j) { const f32x4 g4 = ((const f32x4*)gg)[F.lane + 64 * j], b4 = ((const f32x4*)gb)[F.lane + 64 * j];
                v[j] = v[j] * rstd * g4 + b4; ((f32x4*)(X + (size_t)row * D))[F.lane + 64 * j] = v[j];
                const f32x4 sh = ((const f32x4*)shp)[F.lane + 64 * j], sc = ((const f32x4*)scp)[F.lane + 64 * j]; hv[j] = v[j] * (sc + 1.0f) + sh;
                o8[64 * j] = (unsigned long long)cvtpk_s(hv[j][0], hv[j][1]) | ((unsigned long long)cvtpk_s(hv[j][2], hv[j][3]) << 32); }
            float lg[16];
#pragma unroll
            for (int e = 0; e < 16; ++e) { float p = 0.f;
#pragma unroll
                for (int j = 0; j < 4; ++j) { const f32x4 w = *(const LAS f32x4*)(RWt + e * 1024 + 4 * F.lane + 256 * j); p += (hv[j][0] * w[0] + hv[j][1] * w[1]) + (hv[j][2] * w[2] + hv[j][3] * w[3]); }
                lg[e] = wave_sum(p); }
            int e0 = 0, e1 = 1; float a0 = 0.f, a1 = 0.f, best = -INFINITY;
#pragma unroll
            for (int g4 = 0; g4 < 4; ++g4) { float af[4], sl[4];
#pragma unroll
                for (int k = 0; k < 4; ++k) { af[k] = 1.0f / (1.0f + __expf(-lg[4 * g4 + k])); sl[k] = af[k] + rb[4 * g4 + k]; }
                int i0 = 0; float m0 = sl[0];
#pragma unroll
                for (int k = 1; k < 4; ++k) if (sl[k] > m0) { m0 = sl[k]; i0 = k; }
                int i1 = -1; float m1 = -INFINITY;
#pragma unroll
                for (int k = 0; k < 4; ++k) if (k != i0 && sl[k] > m1) { m1 = sl[k]; i1 = k; }
                const float gs = m0 + m1;
                if (gs > best) { best = gs; e0 = 4 * g4 + i0; e1 = 4 * g4 + i1;
                    float x0 = af[0], x1 = af[0];
#pragma unroll
                    for (int k = 1; k < 4; ++k) { x0 = (i0 == k) ? af[k] : x0; x1 = (i1 == k) ? af[k] : x1; }
                    a0 = x0; a1 = x1; } }
            if (F.lane == 0) { const float inv = 1.0f / (a0 + a1);
                RouteT r; r.e0 = e0; r.e1 = e1; r.w0 = a0 * inv; r.w1 = a1 * inv; RT[row] = r;
                const int p0 = atomicAdd((int*)&lcnt[e0], 1), p1 = atomicAdd((int*)&lcnt[e1], 1);
                ent[(F.wave * 16 + it) * 2 + 0] = (e0 << 16) | p0; ent[(F.wave * 16 + it) * 2 + 1] = (e1 << 16) | p1; }
        }
        __syncthreads();
        if (F.tid < 16) gbase[F.tid] = (int)__hip_atomic_fetch_add(F.ctl + CW_CNT + (layer * 16 + F.tid) * 64, (unsigned)lcnt[F.tid], RLX_AGENT);
        __syncthreads();
        if (F.tid < 256) { const int en = ent[F.tid], e = en >> 16, lp = en & 0xffff; LIST[(size_t)e * 65536 + gbase[e] + lp] = (rbk * 128 + (F.tid >> 1)) * 2 + (F.tid & 1); }
        __syncthreads();
    }
}
__device__ __forceinline__ void moeprep_phase(Frame& F, int layer, const bf16* H2, bf16* HS) {
    int cn[16], tb[17]; tb[0] = 0;
#pragma unroll
    for (int e = 0; e < 16; ++e) { cn[e] = (int)__builtin_amdgcn_readfirstlane(__hip_atomic_load(F.ctl + CW_CNT + (layer * 16 + e) * 64, RLX_AGENT)); tb[e + 1] = tb[e] + ((cn[e] + 255) >> 8); }
    const int NT = tb[16];
    int* TE = (int*)(F.ws + WS_TAB + TAB_TE) + layer * 512; int* NTW = (int*)(F.ws + WS_TAB + TAB_NT);
    const RouteT* RT = (const RouteT*)(F.ws + WS_RT); const int* LIST = (const int*)(F.ws + WS_LIST);
    int* SLOTP = (int*)(F.ws + WS_SLOTP); float* SLOTW = (float*)(F.ws + WS_SLOTW);
    if (F.vcu == 0) {
        for (int T = F.tid; T < NT; T += NWAVES * 64) { int e = 0;
#pragma unroll
            for (int k = 1; k < 16; ++k) if (T >= tb[k]) e = k;
            TE[T] = e; }
        if (F.tid == 0) NTW[layer] = NT;
    }
    for (int s = F.gw; s < NT * 256; s += F.NGW) {
        const int T = s >> 8; int e = 0, tbe = 0, ce = cn[0];
#pragma unroll
        for (int k = 1; k < 16; ++k) if (T >= tb[k]) { e = k; tbe = tb[k]; ce = cn[k]; }
        const int pos = s - tbe * 256; const bool valid = pos < ce;
        int pair = -1; float w = 0.f; v4u a = (v4u){0u, 0u, 0u, 0u}, b = a;
        if (valid) { pair = LIST[(size_t)e * 65536 + pos]; const int row = pair >> 1; const RouteT r = RT[row]; w = (pair & 1) ? r.w1 : r.w0;
            a = *(const v4u*)(H2 + (size_t)row * D + 8 * F.lane); b = *(const v4u*)(H2 + (size_t)row * D + 512 + 8 * F.lane); }
        *(v4u*)(HS + (size_t)s * D + 8 * F.lane) = a; *(v4u*)(HS + (size_t)s * D + 512 + 8 * F.lane) = b;
        if (F.lane == 0) { SLOTP[s] = pair; SLOTW[s] = w; }
    }
}
constexpr int MOETAB_OFF = LDSCTL_OFF + 1024;
__device__ __forceinline__ pg8::MoeTab moe_tables(Frame& F, int layer, int& NT) {
    LAS int* tb = (LAS int*)(F.lds + MOETAB_OFF); LAS int* cn = tb + 32; LAS int* te = tb + 64;
    if (F.tid < 16) cn[F.tid] = (int)__hip_atomic_load(F.ctl + CW_CNT + (layer * 16 + F.tid) * 64, RLX_AGENT);
    __syncthreads();
    if (F.tid == 0) { int a = 0; for (int e = 0; e < 16; ++e) { tb[e] = a; a += (cn[e] + 255) >> 8; } tb[16] = a; }
    __syncthreads();
    NT = __builtin_amdgcn_readfirstlane(tb[16]);
    for (int T = F.tid; T < NT; T += NWAVES * 64) { int e = 0;
        for (int k = 1; k < 16; ++k) if (T >= tb[k]) e = k;
        te[T] = e; }
    __syncthreads();
    pg8::MoeTab t{(const LAS int*)tb, (const LAS int*)cn, (const LAS int*)te, (const int*)(F.ws + WS_LIST)};
    return t;
}
__device__ __forceinline__ void ln2_phase(Frame& F, int layer, float* X, const bf16* Y2, const float* ln_g, const float* ln_b, bool write_next) {
    const float* adab = (const float*)(F.ws + WS_TAB + TAB_ADA);
    const float* gg = ln_g + (size_t)(layer * 2 + 1) * D; const float* gb = ln_b + (size_t)(layer * 2 + 1) * D;
    bf16* HQ = (bf16*)(F.ws + WS_H); bf16* HKV = (bf16*)(F.ws + WS_HKV);
    for (int row = F.gw; row < M; row += F.NGW) { const int b = row >> 13;
        const float* g2 = adab + (size_t)b * ADA_STRIDE + layer * 6144 + 5120;
        f32x4 v[4]; float s = 0.f;
#pragma unroll
        for (int j = 0; j < 4; ++j) { const f32x4 xv = ((const f32x4*)(X + (size_t)row * D))[F.lane + 64 * j]; const f32x4 gv = ((const f32x4*)g2)[F.lane + 64 * j] + 1.0f;
            const u32x2v ya = ((const u32x2v*)(Y2 + (size_t)(2 * row) * D))[F.lane + 64 * j], yb = ((const u32x2v*)(Y2 + (size_t)(2 * row + 1) * D))[F.lane + 64 * j];
            f32x4 y; y[0] = bflo(ya[0]) + bflo(yb[0]); y[1] = bfhi(ya[0]) + bfhi(yb[0]); y[2] = bflo(ya[1]) + bflo(yb[1]); y[3] = bfhi(ya[1]) + bfhi(yb[1]);
            v[j] = xv * ALPHA + gv * y; s += (v[j][0] + v[j][1]) + (v[j][2] + v[j][3]); }
        const float mean = wave_sum(s) * (1.f / D); float s2 = 0.f;
#pragma unroll
        for (int j = 0; j < 4; ++j) { v[j] = v[j] - mean; s2 += (v[j][0] * v[j][0] + v[j][1] * v[j][1]) + (v[j][2] * v[j][2] + v[j][3] * v[j][3]); }
        const float rstd = 1.f / sqrtf(wave_sum(s2) * (1.f / D) + LN_EPS);
#pragma unroll
        for (int j = 0; j < 4; ++j) { const f32x4 g4 = ((const f32x4*)gg)[F.lane + 64 * j], b4 = ((const f32x4*)gb)[F.lane + 64 * j];
            v[j] = v[j] * rstd * g4 + b4; ((f32x4*)(X + (size_t)row * D))[F.lane + 64 * j] = v[j]; }
        if (write_next) {
            store_mod_bf16(HQ + (size_t)row * D, v, adab + (size_t)b * ADA_STRIDE + 6144 + 0, adab + (size_t)b * ADA_STRIDE + 6144 + 1024, F.lane);
            store_mod_bf16(HKV + (size_t)row * D, v, adab + (size_t)b * ADA_STRIDE + 12288 + 0, adab + (size_t)b * ADA_STRIDE + 12288 + 1024, F.lane);
        }
    }
}

__device__ __forceinline__ int crow(int r, int hi) { return (r & 3) + 8 * (r >> 2) + 4 * hi; }
__device__ __forceinline__ unsigned off_b(unsigned row, unsigned ch) { return 256u * row + 16u * (ch ^ (((row & 3) << 2) | ((row >> 2) & 3))); }
typedef __attribute__((address_space(3))) const char* lds_cptr;
__device__ __forceinline__ s16x4 vtr(lds_cptr p) { return __builtin_bit_cast(s16x4, __builtin_amdgcn_ds_read_tr16_b64_v4i16((__attribute__((address_space(3))) v4i16_t*)p)); }
__device__ __forceinline__ void attn_tile(bf16* Qh, const bf16* Kh, const bf16* Vh, float* LSEh, const float* BT, int g, int bl, int h, int r, int i, LAS unsigned char* vl, int lane) {
    const int sh = 2 * g, ql = lane & 31, hh = lane >> 5, colb = g * 1024 + h * HD;
    const size_t row0 = (size_t)bl * SEQ + r;
    const size_t qrow = row0 + ((size_t)(32 * i + ql) << sh);
    bf16x8 qf[8];
#pragma unroll
    for (int s = 0; s < 8; ++s) qf[s] = *(const bf16x8*)(Qh + qrow * QW + colb + 8 * hh + 16 * s);
    f32x16 o[4];
#pragma unroll
    for (int c = 0; c < 4; ++c)
#pragma unroll
        for (int k = 0; k < 16; ++k) o[c][k] = 0.f;
    float m = -1e30f, l = 0.f;
    const float* bt = BT + (g * 8 + h) * 129;
    const float scl = 0.08838834764831845f * LOG2E;
    const int tq = (lane & 15) >> 2, tp = lane & 3, tblk = (lane >> 4) & 1;
    for (int kt = 4; kt >= 0; --kt) {
        const int kp0 = 32 * i - 128 + 32 * kt;
        if (kp0 + 31 < 0) break;
        int kp = kp0 + ql; kp = kp < 0 ? 0 : kp;
        const bf16* kptr = Kh + (row0 + ((size_t)kp << sh)) * QW + colb + 8 * hh;
        bf16x8 kf[8];
#pragma unroll
        for (int s = 0; s < 8; ++s) kf[s] = *(const bf16x8*)(kptr + 16 * s);
        v4u vv[8];
#pragma unroll
        for (int ii = 0; ii < 8; ++ii) { const int n = lane + 64 * ii, vr = n >> 4, ch = n & 15; int kr = kp0 + vr; kr = kr < 0 ? 0 : kr;
            vv[ii] = *(const v4u*)(Vh + (row0 + ((size_t)kr << sh)) * QW + colb + ch * 8); }
        f32x16 sc;
#pragma unroll
        for (int k = 0; k < 16; ++k) sc[k] = 0.f;
#pragma unroll
        for (int s = 0; s < 8; ++s) sc = __builtin_amdgcn_mfma_f32_32x32x16_bf16(kf[s], qf[s], sc, 0, 0, 0);
#pragma unroll
        for (int ii = 0; ii < 8; ++ii) { const int n = lane + 64 * ii, vr = n >> 4, ch = n & 15; *(LAS v4u*)(vl + off_b(vr, ch)) = vv[ii]; }
        float mx = -INFINITY;
#pragma unroll
        for (int k = 0; k < 16; ++k) { const int kloc = crow(k, hh); const int dist = 128 + ql - 32 * kt - kloc; const bool valid = (dist >= 0) && (dist <= 128) && (kp0 + kloc >= 0);
            const int dc = dist < 0 ? 0 : (dist > 128 ? 128 : dist);
            const float v = valid ? sc[k] * scl + bt[dc] : -INFINITY; sc[k] = v; mx = fmaxf(mx, v); }
        mx = fmaxf(mx, __shfl_xor(mx, 32));
        const float mn = fmaxf(m, mx), alpha = __builtin_amdgcn_exp2f(m - mn); m = mn;
        float ls = 0.f;
#pragma unroll
        for (int k = 0; k < 16; ++k) { const float p = __builtin_amdgcn_exp2f(sc[k] - mn); sc[k] = p; ls += p; }
        ls += __shfl_xor(ls, 32); l = l * alpha + ls;
#pragma unroll
        for (int c = 0; c < 4; ++c)
#pragma unroll
            for (int k = 0; k < 16; ++k) o[c][k] *= alpha;
        bf16x8 pf[2];
#pragma unroll
        for (int s = 0; s < 2; ++s) { v4u w; w.x = cvtpk_s(sc[8 * s + 0], sc[8 * s + 1]); w.y = cvtpk_s(sc[8 * s + 2], sc[8 * s + 3]); w.z = cvtpk_s(sc[8 * s + 4], sc[8 * s + 5]); w.w = cvtpk_s(sc[8 * s + 6], sc[8 * s + 7]); pf[s] = __builtin_bit_cast(bf16x8, w); }
#pragma unroll
        for (int c = 0; c < 4; ++c)
#pragma unroll
            for (int s = 0; s < 2; ++s) {
                const s16x4 lo = vtr((lds_cptr)(vl + off_b(16 * s + 0 + 4 * hh + tq, 4 * c + 2 * tblk + (tp >> 1)) + 8 * (tp & 1)));
                const s16x4 hi = vtr((lds_cptr)(vl + off_b(16 * s + 8 + 4 * hh + tq, 4 * c + 2 * tblk + (tp >> 1)) + 8 * (tp & 1)));
                const bf16x8 va = (bf16x8){lo[0], lo[1], lo[2], lo[3], hi[0], hi[1], hi[2], hi[3]};
                o[c] = __builtin_amdgcn_mfma_f32_32x32x16_bf16(va, pf[s], o[c], 0, 0, 0);
            }
    }
    const float inv = 1.0f / l;
    bf16* op = Qh + qrow * QW + colb;
#pragma unroll
    for (int c = 0; c < 4; ++c)
#pragma unroll
        for (int gq = 0; gq < 4; ++gq) { u32x2v w; w.x = cvtpk_s(o[c][4 * gq + 0] * inv, o[c][4 * gq + 1] * inv); w.y = cvtpk_s(o[c][4 * gq + 2] * inv, o[c][4 * gq + 3] * inv);
            *(u32x2v*)(op + 32 * c + 8 * gq + 4 * hh) = w; }
    if (hh == 0) LSEh[qrow * 24 + g * 8 + h] = (m + __builtin_amdgcn_logf(l)) * LN2;
}
__device__ __forceinline__ void attn_stage(const bf16* base, size_t row0, int sh, int kpbase, LAS unsigned char* R, int wave, int lane) {
    asm volatile("" : "+v"(lane));
    const int rr = lane >> 4, cp = lane & 15;
#pragma unroll
    for (int q = 0; q < 12; ++q) { const int n = wave + 8 * q; const int row = 4 * n + rr; int kp = kpbase + row; kp = kp < 0 ? 0 : kp;
        const int ch = cp ^ (((row & 3) << 2) | ((row >> 2) & 3));
        const bf16* src = base + (row0 + ((size_t)kp << sh)) * QW + ch * 8;
        __builtin_amdgcn_global_load_lds((const unsigned*)src, (LAS unsigned*)(R + n * 1024), 16, 0, 0); }
}
template <int KT> __device__ __forceinline__ void attn_scores(f32x16& sc, const LAS float* bias, int ql, int hh, int kp0, float scl, float& mx) {
    const LAS float* bl = bias + (160 - 32 * KT + ql - 4 * hh);
    const int d0 = 128 - 32 * KT + ql - 4 * hh, kq = kp0 + 4 * hh;
    float bv[16];
#pragma unroll
    for (int k = 0; k < 16; ++k) bv[k] = bl[-((k & 3) + 8 * (k >> 2))];
#pragma unroll
    for (int k = 0; k < 16; ++k) { const int ko = (k & 3) + 8 * (k >> 2);
        bool valid = (kq + ko >= 0);
        if (KT == 0) valid = valid && (d0 - ko <= 128);
        if (KT == 4) valid = valid && (d0 - ko >= 0);
        const float t = sc[k] * scl + bv[k];
        const float v = valid ? t : -INFINITY; sc[k] = v; mx = fmaxf(mx, v); }
}
template <int KT> __device__ __forceinline__ void attn_s_step(const LAS unsigned char* Rw, const unsigned (&ka)[8], const bf16x8 (&qf)[8], const LAS float* biasl, int ql, int hh, int kpw, float scl, float& m, float& l, float& al, bf16x8 (&pf)[2]) {
    f32x16 a;
#pragma unroll
    for (int k = 0; k < 16; ++k) a[k] = 0.f;
#pragma unroll
    for (int s = 0; s < 8; ++s) { const bf16x8 kf = *(const LAS bf16x8*)(Rw + KT * 8192 + ka[s]); a = __builtin_amdgcn_mfma_f32_32x32x16_bf16(kf, qf[s], a, 0, 0, 0); }
    float mx = -INFINITY;
    attn_scores<KT>(a, biasl, ql, hh, kpw + 32 * KT, scl, mx);
    mx = fmaxf(mx, __shfl_xor(mx, 32));
    const float mn = fmaxf(m, mx); al = __builtin_amdgcn_exp2f(m - mn); m = mn;
    float ls = 0.f;
#pragma unroll
    for (int k = 0; k < 16; ++k) { const float p = __builtin_amdgcn_exp2f(a[k] - mn); a[k] = p; ls += p; }
    ls += __shfl_xor(ls, 32); l = l * al + ls;
#pragma unroll
    for (int s = 0; s < 2; ++s) { v4u w; w.x = cvtpk_s(a[8 * s + 0], a[8 * s + 1]); w.y = cvtpk_s(a[8 * s + 2], a[8 * s + 3]); w.z = cvtpk_s(a[8 * s + 4], a[8 * s + 5]); w.w = cvtpk_s(a[8 * s + 6], a[8 * s + 7]); pf[s] = __builtin_bit_cast(bf16x8, w); }
}
template <int KT> __device__ __forceinline__ void attn_pv_step(const LAS unsigned char* Rw, const unsigned (&va)[4][2], const bf16x8 (&pf)[2], float al, f32x16 (&o)[4]) {
#pragma unroll
    for (int c = 0; c < 4; ++c) {
        if (KT != 4) {
#pragma unroll
            for (int k = 0; k < 16; ++k) o[c][k] *= al; }
#pragma unroll
        for (int s = 0; s < 2; ++s) {
            const s16x4 lo = vtr((lds_cptr)(Rw + KT * 8192 + s * 4096 + va[c][0]));
            const s16x4 hi = vtr((lds_cptr)(Rw + KT * 8192 + s * 4096 + va[c][1]));
            const bf16x8 vv = (bf16x8){lo[0], lo[1], lo[2], lo[3], hi[0], hi[1], hi[2], hi[3]};
            o[c] = __builtin_amdgcn_mfma_f32_32x32x16_bf16(vv, pf[s], o[c], 0, 0, 0);
        }
    }
}
__device__ __forceinline__ void attn_unit(bf16* Qh, const bf16* Kh, const bf16* Vh, float* LSEh, const float* BT, int g, int bl, int h, int r, int j, LAS unsigned char* R, LAS float* biasl, int wave, int lane_in, int tid) {
    int lane = lane_in; asm volatile("" : "+v"(lane));
    const int sh = 2 * g, colb = g * 1024 + h * HD;
    const size_t row0 = (size_t)bl * SEQ + r;
    const int i = 8 * j + wave;
    attn_stage(Kh + colb, row0, sh, 256 * j - 128, R, wave, lane);
    if (tid < 129) biasl[32 + tid] = BT[(g * 8 + h) * 129 + tid];
    bf16x8 qf[8];
    { const int ql = lane & 31, hh = lane >> 5; const size_t qrow = row0 + ((size_t)(32 * i + ql) << sh);
#pragma unroll
      for (int s = 0; s < 8; ++s) qf[s] = *(const bf16x8*)(Qh + qrow * QW + colb + 8 * hh + 16 * s); }
    asm volatile("s_waitcnt vmcnt(0) lgkmcnt(0)" ::: "memory"); __builtin_amdgcn_s_barrier(); asm volatile("" ::: "memory");
    const LAS unsigned char* Rw = R + wave * 8192;
    float m = -1e30f, l = 0.f, al4, al3, al2, al1, al0;
    bf16x8 p4[2], p3[2], p2[2], p1[2], p0[2];
    {
        int ls = lane; asm volatile("" : "+v"(ls));
        const int ql = ls & 31, hh = ls >> 5;
        unsigned ka[8];
#pragma unroll
        for (int s = 0; s < 8; ++s) ka[s] = off_b(ql, 2 * s + hh);
        const float scl = 0.08838834764831845f * LOG2E;
        const int kpw = 32 * i - 128;
        attn_s_step<4>(Rw, ka, qf, biasl, ql, hh, kpw, scl, m, l, al4, p4);
        attn_s_step<3>(Rw, ka, qf, biasl, ql, hh, kpw, scl, m, l, al3, p3);
        attn_s_step<2>(Rw, ka, qf, biasl, ql, hh, kpw, scl, m, l, al2, p2);
        attn_s_step<1>(Rw, ka, qf, biasl, ql, hh, kpw, scl, m, l, al1, p1);
        attn_s_step<0>(Rw, ka, qf, biasl, ql, hh, kpw, scl, m, l, al0, p0);
    }
    asm volatile("s_waitcnt lgkmcnt(0)" ::: "memory"); __builtin_amdgcn_s_barrier(); asm volatile("" ::: "memory");
    attn_stage(Vh + colb, row0, sh, 256 * j - 128, R, wave, lane);
    f32x16 o[4];
#pragma unroll
    for (int c = 0; c < 4; ++c)
#pragma unroll
        for (int k = 0; k < 16; ++k) o[c][k] = 0.f;
    asm volatile("s_waitcnt vmcnt(0)" ::: "memory"); __builtin_amdgcn_s_barrier(); asm volatile("" ::: "memory");
    int lp = lane; asm volatile("" : "+v"(lp));
    {
        const int hh = lp >> 5, tq = (lp & 15) >> 2, tp = lp & 3, tblk = (lp >> 4) & 1;
        unsigned va[4][2];
#pragma unroll
        for (int c = 0; c < 4; ++c)
#pragma unroll
            for (int t = 0; t < 2; ++t) va[c][t] = off_b(8 * t + 4 * hh + tq, 4 * c + 2 * tblk + (tp >> 1)) + 8 * (tp & 1);
        attn_pv_step<4>(Rw, va, p4, al4, o);
        attn_pv_step<3>(Rw, va, p3, al3, o);
        attn_pv_step<2>(Rw, va, p2, al2, o);
        attn_pv_step<1>(Rw, va, p1, al1, o);
        attn_pv_step<0>(Rw, va, p0, al0, o);
    }
    const float inv = 1.0f / l;
    const int ql = lp & 31, hh = lp >> 5; const size_t qrow = row0 + ((size_t)(32 * i + ql) << sh);
    bf16* op = Qh + qrow * QW + colb;
#pragma unroll
    for (int c = 0; c < 4; ++c)
#pragma unroll
        for (int gq = 0; gq < 4; ++gq) { u32x2v w; w.x = cvtpk_s(o[c][4 * gq + 0] * inv, o[c][4 * gq + 1] * inv); w.y = cvtpk_s(o[c][4 * gq + 2] * inv, o[c][4 * gq + 3] * inv);
            *(u32x2v*)(op + 32 * c + 8 * gq + 4 * hh) = w; }
    if (hh == 0) LSEh[qrow * 24 + g * 8 + h] = (m + __builtin_amdgcn_logf(l)) * LN2;
    asm volatile("s_waitcnt lgkmcnt(0)" ::: "memory"); __builtin_amdgcn_s_barrier(); asm volatile("" ::: "memory");
}
__device__ __forceinline__ void attn_phase(Frame& F) {
    bf16* Qh = (bf16*)(F.ws + WS_Q); const bf16* Kh = (const bf16*)(F.ws + WS_K); const bf16* Vh = (const bf16*)(F.ws + WS_V);
    float* LSEh = (float*)(F.ws + WS_LSE); const float* BT = (const float*)(F.ws + WS_TAB + TAB_BT);
    LAS unsigned char* R = F.lds + RING_OFF; LAS float* biasl = (LAS float*)(F.lds + RING_OFF + 98304);
    for (int u = F.vcu; u < 1536; u += F.G) {
        const int g = u / 512, rem = u % 512, sh = 2 * g, hq = rem >> 5, q32 = rem & 31, nblk = 32 >> sh;
        attn_unit(Qh, Kh, Vh, LSEh, BT, g, hq >> 3, hq & 7, q32 / nblk, q32 % nblk, R, biasl, F.wave, F.lane, F.tid);
    }
}
__device__ __forceinline__ void mix_phase(Frame& F, int half) {
    const bf16* Oh = (const bf16*)(F.ws + WS_Q); const float* LSEh = (const float*)(F.ws + WS_LSE); bf16* MIX = (bf16*)(F.ws + WS_H);
    for (int lr = F.gw; lr < HALF_ROWS; lr += F.NGW) {
#pragma unroll
        for (int j = 0; j < 2; ++j) { const int col = 512 * j + 8 * F.lane, h = col >> 7;
            const float l0 = LSEh[(size_t)lr * 24 + h], l1 = LSEh[(size_t)lr * 24 + 8 + h], l2 = LSEh[(size_t)lr * 24 + 16 + h];
            const float mx = fmaxf(l0, fmaxf(l1, l2)); float e0 = __expf(l0 - mx), e1 = __expf(l1 - mx), e2 = __expf(l2 - mx); const float inv = 1.0f / (e0 + e1 + e2); e0 *= inv; e1 *= inv; e2 *= inv;
            const v4u a = *(const v4u*)(Oh + (size_t)lr * QW + col), b = *(const v4u*)(Oh + (size_t)lr * QW + 1024 + col), c = *(const v4u*)(Oh + (size_t)lr * QW + 2048 + col); v4u o;
#pragma unroll
            for (int k = 0; k < 4; ++k) o[k] = cvtpk_s(e0 * bflo(a[k]) + e1 * bflo(b[k]) + e2 * bflo(c[k]), e0 * bfhi(a[k]) + e1 * bfhi(b[k]) + e2 * bfhi(c[k]));
            *(v4u*)(MIX + (size_t)(half * HALF_ROWS + lr) * D + col) = o; }
    }
}

struct Args { const float* in[20]; float* out; unsigned char* ws; int ph_lo, ph_hi, li, pad; };
__global__ void __launch_bounds__(NWAVES * 64, 2) yoco_fwd(Args args) {
    extern __shared__ __attribute__((aligned(16))) unsigned char lds[];
    Frame F;
    F.lds = (LAS unsigned char*)lds;
    F.MISC = (volatile LAS unsigned*)(F.lds + MISC_OFF);
    F.tid = threadIdx.x; F.lane = F.tid & 63; F.wave = __builtin_amdgcn_readfirstlane(F.tid >> 6);
    F.G = gridDim.x; { const int bx = blockIdx.x; F.vcu = (F.G % 8 == 0) ? (bx % 8) * (F.G / 8) + bx / 8 : bx; }
    F.gw = F.vcu * NWAVES + F.wave; F.NGW = F.G * NWAVES;
    F.ws = args.ws; F.ctl = (gu32*)(args.ws + WS_CTL);
    for (int u = F.tid; u < (LDS_BYTES - LDSCTL_OFF) / 4; u += NWAVES * 64) ((LAS unsigned*)(F.lds + LDSCTL_OFF))[u] = 0u;
    __syncthreads();
    XcdBarrier bar; bar.bar = (unsigned*)(F.ctl + CW_BAR); bar.x = 0; bar.st = nullptr;
    if (N_LAUNCHES == 1) bar = xcd_barrier_post((unsigned*)(F.ctl + CW_BAR), F.MISC + 8);
#define GRID_BAR() do { if (N_LAUNCHES == 1) { xcd_barrier(bar); } } while (0)
    const int lo = args.ph_lo, hi = args.ph_hi;
#ifndef PH_MASK
#define PH_MASK 0xffffffffu
#endif
#define IN(k) ((((PH_MASK) >> (k)) & 1u) && lo <= (k) && (k) < hi)
#define BOTH(k) (IN(k) && IN((k) + 1))
#ifndef REP_MASK
#define REP_MASK 0u
#endif
#ifndef REP_PAIR
#define REP_PAIR 0
#endif
#define REPQ(k) ((((REP_MASK) >> (k)) & 1u) != 0u)
    const float* x = args.in[0]; const float* ln_g = args.in[4]; const float* ln_b = args.in[5];
    float* X = args.out;
    unsigned char* ws = args.ws;
    const float* ADA = (const float*)(ws + WS_TAB + TAB_ADA);

    if (IN(0)) { P0In I{args.in[1], args.in[2], args.in[3], args.in[6], args.in[8], args.in[9], args.in[10], args.in[11], args.in[12], args.in[13], args.in[14], args.in[17], args.in[18], args.in[19]};
        if constexpr (REPQ(0)) { p0_prologue(F, I); GRID_BAR(); } p0_prologue(F, I); if (BOTH(0)) GRID_BAR(); }
    if (IN(1)) { if constexpr (REPQ(1)) { p1_mod0(F, x); GRID_BAR(); } p1_mod0(F, x); if (BOTH(1)) GRID_BAR(); }
    if (IN(2)) {
        pg8::Gemm g{(const bf16*)(ws + WS_H), (const bf16*)(ws + WS_WIN), M, 3072, D}; pg8::StaticOrder S; S.init(M, 3072, F.G, (int)blockIdx.x);
        pg8::EpiCV E{(bf16*)(ws + WS_U), (bf16*)(ws + WS_BG)};
        if constexpr (REPQ(2)) { pg8::gemm_phase<pg8::EpiCV, pg8::StaticOrder, true, true>(F.lds + RING_OFF, g, S, E); GRID_BAR(); }
        pg8::gemm_phase<pg8::EpiCV, pg8::StaticOrder, true, true>(F.lds + RING_OFF, g, S, E);
        if (BOTH(2)) GRID_BAR(); }
    if (IN(3)) { if constexpr (REPQ(3)) { p3_conv(F, args.in[7]); GRID_BAR(); } p3_conv(F, args.in[7]); if (BOTH(3)) GRID_BAR(); }
    if (IN(4)) {
        pg8::Gemm g{(const bf16*)(ws + WS_H), (const bf16*)(ws + WS_WOUT), M, D, D}; pg8::StaticOrder S; S.init(M, D, F.G, (int)blockIdx.x);
        pg8::EpiRes E{x, X, ADA + 2048, ADA_STRIDE, SEQ, ALPHA};
        if constexpr (REPQ(4)) { pg8::gemm_phase<pg8::EpiRes, pg8::StaticOrder, true, true>(F.lds + RING_OFF, g, S, E); GRID_BAR(); }
        pg8::gemm_phase<pg8::EpiRes, pg8::StaticOrder, true, true>(F.lds + RING_OFF, g, S, E);
        if (BOTH(4)) GRID_BAR(); }
    if (IN(5)) { lnr_phase(F, 0, X, (bf16*)(ws + WS_H), ln_g, ln_b, args.in[15], args.in[16]); if (IN(5) && IN(7)) GRID_BAR(); }
#define MOE_UP(layer, H2p, HEp) do { int NT; const pg8::MoeTab mt = moe_tables(F, layer, NT); \
        pg8::Gemm g{(const bf16*)(H2p), (const bf16*)(ws + WS_WGU) + (size_t)(layer) * 16 * 512 * 1024, M, 16 * 512, D}; \
        pg8::MoeSchedG S{mt, NT, 2, F.G, F.vcu}; pg8::EpiMoeUp E{(bf16*)(HEp)}; \
        pg8::gemm_phase<pg8::EpiMoeUp, pg8::MoeSchedG, true, true, true>(F.lds + RING_OFF, g, S, E); } while (0)
#define MOE_DN(layer, HEp, Y2p) do { int NT; const pg8::MoeTab mt = moe_tables(F, layer, NT); \
        pg8::Gemm g{(const bf16*)(HEp), (const bf16*)(ws + WS_WD) + (size_t)(layer) * 16 * 1024 * 256, MAXTILES * 256, 16 * 1024, FF}; \
        pg8::MoeSchedG S{mt, NT, 4, F.G, F.vcu}; pg8::EpiMoeDown2 E{mt, (const pg8::RouteT4*)(ws + WS_RT), (bf16*)(Y2p)}; \
        pg8::gemm_phase<pg8::EpiMoeDown2, pg8::MoeSchedG, true, true, false>(F.lds + RING_OFF, g, S, E); } while (0)
    if (IN(7)) { if constexpr (REPQ(7)) { MOE_UP(0, ws + WS_H, ws + WS_HE0); GRID_BAR(); } MOE_UP(0, ws + WS_H, ws + WS_HE0); if (BOTH(7)) GRID_BAR(); }
    if (IN(8)) { if constexpr (REPQ(8)) { MOE_DN(0, ws + WS_HE0, ws + WS_Y20); GRID_BAR(); } MOE_DN(0, ws + WS_HE0, ws + WS_Y20); if (BOTH(8)) GRID_BAR(); }
    if (IN(9)) { ln2_phase(F, 0, X, (const bf16*)(ws + WS_Y20), ln_g, ln_b, true); if (BOTH(9)) GRID_BAR(); }
#define KVQ_PHASE(half) do { \
        { pg8::Gemm g{(const bf16*)(ws + WS_HKV) + (size_t)(half) * HALF_ROWS * D, (const bf16*)(ws + WS_WKV), HALF_ROWS, 6144, D}; pg8::StaticOrder S; S.init(HALF_ROWS, 6144, F.G, (int)blockIdx.x); \
          pg8::EpiBf16<0> E{(bf16*)(ws + WS_K), QW, nullptr, QW, (size_t)(WS_V - WS_K) / 2, 1.0f}; \
          pg8::gemm_phase<pg8::EpiBf16<0>, pg8::StaticOrder, true, true>(F.lds + RING_OFF, g, S, E); } \
        __syncthreads(); \
        { pg8::Gemm g{(const bf16*)(ws + WS_H) + (size_t)(half) * HALF_ROWS * D, (const bf16*)(ws + WS_WQ), HALF_ROWS, QW, D}; pg8::StaticOrder S; S.init(HALF_ROWS, QW, F.G, (int)blockIdx.x); \
          pg8::EpiBf16<0> E{(bf16*)(ws + WS_Q), QW, nullptr, 0, 0, 1.0f}; \
          pg8::gemm_phase<pg8::EpiBf16<0>, pg8::StaticOrder, true, true>(F.lds + RING_OFF, g, S, E); } } while (0)
    if constexpr (REP_PAIR != 0) { if (IN(10) && IN(11)) { KVQ_PHASE(0); GRID_BAR(); attn_phase(F); GRID_BAR(); } }
    if (IN(10)) { if constexpr (REPQ(10)) { KVQ_PHASE(0); GRID_BAR(); } KVQ_PHASE(0); if (BOTH(10)) GRID_BAR(); }
    if (IN(11)) { attn_phase(F); if (BOTH(11)) GRID_BAR(); }
    if (IN(12)) { if constexpr (REPQ(12)) { mix_phase(F, 0); GRID_BAR(); } mix_phase(F, 0); if (BOTH(12)) GRID_BAR(); }
    if (IN(13)) { KVQ_PHASE(1); if (BOTH(13)) GRID_BAR(); }
    if (IN(14)) { attn_phase(F); if (BOTH(14)) GRID_BAR(); }
    if (IN(15)) { mix_phase(F, 1); if (BOTH(15)) GRID_BAR(); }
    if (IN(16)) {
        pg8::Gemm g{(const bf16*)(ws + WS_H), (const bf16*)(ws + WS_WO), M, D, D}; pg8::StaticOrder S; S.init(M, D, F.G, (int)blockIdx.x);
        pg8::EpiRes E{X, X, ADA + 6144 + 2048, ADA_STRIDE, SEQ, ALPHA};
        pg8::gemm_phase<pg8::EpiRes, pg8::StaticOrder, true, true>(F.lds + RING_OFF, g, S, E);
        if (BOTH(16)) GRID_BAR(); }
    if (IN(17)) { lnr_phase(F, 1, X, (bf16*)(ws + WS_HKV), ln_g, ln_b, args.in[15], args.in[16]); if (IN(17) && IN(19)) GRID_BAR(); }
    if (IN(19)) { MOE_UP(1, ws + WS_HKV, ws + WS_HE0 + MOE_LSTEP); if (BOTH(19)) GRID_BAR(); }
    if (IN(20)) { MOE_DN(1, ws + WS_HE0 + MOE_LSTEP, ws + WS_Y20 + MOE_LSTEP); if (BOTH(20)) GRID_BAR(); }
    if (IN(21)) { ln2_phase(F, 1, X, (const bf16*)(ws + WS_Y20 + MOE_LSTEP), ln_g, ln_b, false); }
#undef IN
#undef BOTH
}

extern "C" void kernel_launch(void* const* d_in, const int* in_sizes, int n_in, void* d_out, int out_size, void* d_ws, size_t ws_size, hipStream_t stream) {
    static int grid = 0;
    if (grid == 0) {
        if (n_in != 20 || in_sizes[0] != M * D || out_size != M * D || ws_size < WS_END) { fprintf(stderr, "kernel_launch: unexpected shapes / workspace (n_in %d, in0 %d, out %d, ws %zu)\n", n_in, n_in > 0 ? in_sizes[0] : -1, out_size, ws_size); grid = -1; return; }
        int dev = 0, cus = 0, per_cu = 0;
        if (hipGetDevice(&dev) != hipSuccess || hipDeviceGetAttribute(&cus, hipDeviceAttributeMultiprocessorCount, dev) != hipSuccess) { grid = -1; return; }
        if (hipFuncSetAttribute((const void*)yoco_fwd, hipFuncAttributeMaxDynamicSharedMemorySize, LDS_BYTES) != hipSuccess) { grid = -1; return; }
        if (hipOccupancyMaxActiveBlocksPerMultiprocessor(&per_cu, (const void*)yoco_fwd, NWAVES * 64, LDS_BYTES) != hipSuccess || per_cu < 1)
            fprintf(stderr, "kernel_launch: occupancy query reports %d workgroups per CU\n", per_cu);
        (void)hipGetLastError();
        grid = cus;
    }
    if (grid < 0) return;
    if (hipMemsetAsync((char*)d_ws + WS_CTL, 0, CTL_ZERO_BYTES, stream) != hipSuccess) return;
    Args a{};
    for (int i = 0; i < 20; ++i) a.in[i] = (const float*)d_in[i];
    a.out = (float*)d_out; a.ws = (unsigned char*)d_ws; a.pad = 0;
    if (N_LAUNCHES == 1) { a.ph_lo = 0; a.ph_hi = NPHASE; a.li = 0;
        hipLaunchKernelGGL(yoco_fwd, dim3(grid), dim3(NWAVES * 64), LDS_BYTES, stream, a);
    } else {
        for (int li = 0; li < NPHASE; ++li) { a.ph_lo = li; a.ph_hi = li + 1; a.li = li;
            hipLaunchKernelGGL(yoco_fwd, dim3(grid), dim3(NWAVES * 64), LDS_BYTES, stream, a); }
    }
}
```
